# Optimizing an MI355X kernel written in HIP

```python
import jax
import jax.numpy as jnp
from jax import lax
import numpy as np

D_MODEL = 1024
BATCH = 8
SEQ = 4096
DEPTH = 1

HEAD_DIM = 64
N_Q_HEADS = D_MODEL // HEAD_DIM
N_KV_HEADS = N_Q_HEADS // 8
WINDOW = 128
ROPE_THETA = 10000.0
ATTN_WIDTH = N_Q_HEADS * HEAD_DIM
KV_WIDTH = N_KV_HEADS * HEAD_DIM
POOL_WINDOWS = (2, 4, 8, 16)
POOL_WIDTH = D_MODEL // 2
POOL_GROUP = POOL_WIDTH // len(POOL_WINDOWS)
N_BRANCHES = 2
IN_WIDTH = ATTN_WIDTH + 2 * KV_WIDTH + POOL_WIDTH + N_BRANCHES * D_MODEL
IN_SPLITS = (ATTN_WIDTH, ATTN_WIDTH + KV_WIDTH, ATTN_WIDTH + 2 * KV_WIDTH,
             ATTN_WIDTH + 2 * KV_WIDTH + POOL_WIDTH)
N_EXPERTS = 32
TOP_K = 4
D_FF = D_MODEL
SWIGLU_LIMIT = 7.0
SWIGLU_ALPHA = 1.702
MOE_BLOCK = 256
RMS_EPS = 1e-5
MAX_POS_OFFSET = 1024

kernel_name = 'hybrid_swa_sink_pool_moe_block'


def rms_norm(x, g):
    xf = x.astype(jnp.float32)
    y = xf * lax.rsqrt(jnp.mean(xf * xf, axis=-1, keepdims=True) + RMS_EPS)
    return (y * g.astype(jnp.float32)).astype(x.dtype)


def apply_rope(t, positions):
    inv_freq = ROPE_THETA ** (-jnp.arange(0, HEAD_DIM, 2, dtype=jnp.float32) / HEAD_DIM)
    ang = positions.astype(jnp.float32)[..., None] * inv_freq
    cos = jnp.cos(ang)[:, :, None, :]
    sin = jnp.sin(ang)[:, :, None, :]
    tf = t.astype(jnp.float32)
    t1, t2 = tf[..., :HEAD_DIM // 2], tf[..., HEAD_DIM // 2:]
    out = jnp.concatenate([t1 * cos - t2 * sin, t2 * cos + t1 * sin], axis=-1)
    return out.astype(t.dtype)


def sliding_window_attention(q, k, v, sinks):
    B, S = q.shape[0], q.shape[1]
    nb = S // WINDOW
    grp = N_Q_HEADS // N_KV_HEADS
    qb = q.reshape(B, nb, WINDOW, N_KV_HEADS, grp, HEAD_DIM)

    def band(t):
        tb = t.reshape(B, nb, WINDOW, N_KV_HEADS, HEAD_DIM)
        prev = jnp.concatenate([jnp.zeros_like(tb[:, :1]), tb[:, :-1]], axis=1)
        return jnp.concatenate([prev, tb], axis=2)

    kk, vv = band(k), band(v)
    scale = HEAD_DIM ** -0.5
    s = jnp.einsum('bnqhgd,bnkhd->bnhgqk', qb, kk,
                   preferred_element_type=jnp.float32) * scale
    qi = jnp.arange(WINDOW)[:, None]
    kj = jnp.arange(2 * WINDOW)[None, :]
    dist = qi + WINDOW - kj
    band_mask = (dist >= 0) & (dist < WINDOW)
    key_valid = (jnp.arange(nb)[:, None] * WINDOW - WINDOW + jnp.arange(2 * WINDOW)[None, :]) >= 0
    mask = band_mask[None] & key_valid[:, None, :]
    s = jnp.where(mask[None, :, None, None], s, -jnp.inf)
    sink = sinks.astype(jnp.float32).reshape(1, 1, N_KV_HEADS, grp, 1, 1)
    m = jnp.maximum(jnp.max(s, axis=-1, keepdims=True), sink)
    p = jnp.exp(s - m)
    denom = jnp.sum(p, axis=-1, keepdims=True) + jnp.exp(sink - m)
    probs = (p / denom).astype(v.dtype)
    o = jnp.einsum('bnhgqk,bnkhd->bnqhgd', probs, vv)
    return o.reshape(B, S, N_Q_HEADS * HEAD_DIM)


def multiscale_pool(u):
    B, S, _ = u.shape
    uf = u.astype(jnp.float32)
    c = jnp.cumsum(uf, axis=1)
    t = jnp.arange(S)
    outs = []
    for gi, w in enumerate(POOL_WINDOWS):
        sl = slice(gi * POOL_GROUP, (gi + 1) * POOL_GROUP)
        cg = c[..., sl]
        lower = jnp.concatenate([jnp.zeros((B, w, POOL_GROUP), jnp.float32), cg[:, :S - w]], axis=1)
        cnt = jnp.minimum(t + 1, w).astype(jnp.float32)[None, :, None]
        outs.append((cg - lower) / cnt - uf[..., sl])
    return jnp.stack(outs, axis=2).astype(u.dtype)


def token_mixer(h, positions, w_in, b_in, attn_sinks, w_o_attn, b_o_attn,
                w_pool_mix, pool_scale, w_pool_up, w_out):
    B, S, _ = h.shape
    z = h @ w_in + b_in
    q, k, v, u, gate_logits = jnp.split(z, IN_SPLITS, axis=-1)
    q = apply_rope(q.reshape(B, S, N_Q_HEADS, HEAD_DIM), positions)
    k = apply_rope(k.reshape(B, S, N_KV_HEADS, HEAD_DIM), positions)
    v = v.reshape(B, S, N_KV_HEADS, HEAD_DIM)
    y_attn = sliding_window_attention(q, k, v, attn_sinks) @ w_o_attn + b_o_attn
    pooled = multiscale_pool(u)
    mixed = jnp.einsum('bsgc,gcd->bsgd', pooled, w_pool_mix).reshape(B, S, POOL_WIDTH)
    y_pool = (mixed * pool_scale) @ w_pool_up
    gates = jax.nn.sigmoid(gate_logits.astype(jnp.float32)).astype(h.dtype)
    gates = gates.reshape(B, S, N_BRANCHES, D_MODEL)
    merged = gates[:, :, 0] * y_attn + gates[:, :, 1] * y_pool
    return merged @ w_out


def moe_ffn(h, w_router, b_router, w_gate, b_gate, w_up, b_up, w_down, b_down):
    B, S, D = h.shape
    N = B * S
    hf = h.reshape(N, D)
    logits = (hf @ w_router + b_router).astype(jnp.float32)
    top_v, top_e = lax.top_k(logits, TOP_K)
    comb = jax.nn.softmax(top_v, axis=-1)
    M = N * TOP_K
    flat_e = top_e.reshape(M).astype(jnp.int32)
    flat_w = comb.reshape(M)
    flat_tok = jnp.arange(M, dtype=jnp.int32) // TOP_K
    order = jnp.argsort(flat_e)
    s_e, s_tok, s_w = flat_e[order], flat_tok[order], flat_w[order]
    sizes = jnp.bincount(flat_e, length=N_EXPERTS).astype(jnp.int32)
    starts = jnp.cumsum(sizes) - sizes
    padded = (sizes + MOE_BLOCK - 1) // MOE_BLOCK * MOE_BLOCK
    pends = jnp.cumsum(padded)
    pstarts = pends - padded
    dest = pstarts[s_e] + jnp.arange(M, dtype=jnp.int32) - starts[s_e]
    n_blocks = (M + N_EXPERTS * (MOE_BLOCK - 1) + MOE_BLOCK - 1) // MOE_BLOCK
    P = n_blocks * MOE_BLOCK
    row_tok = jnp.full((P,), N, jnp.int32).at[dest].set(s_tok)
    row_w = jnp.zeros((P,), jnp.float32).at[dest].set(s_w)
    block_e = jnp.searchsorted(pends, jnp.arange(n_blocks, dtype=jnp.int32) * MOE_BLOCK, side='right')
    block_e = jnp.minimum(block_e, N_EXPERTS - 1).astype(jnp.int32)
    h_pad = jnp.concatenate([hf, jnp.zeros((1, D), hf.dtype)], axis=0)
    xs = h_pad[row_tok].reshape(n_blocks, MOE_BLOCK, D)

    def expert_block(args):
        xb, e = args
        g = xb @ w_gate[e] + b_gate[e]
        u = xb @ w_up[e] + b_up[e]
        g = jnp.minimum(g, SWIGLU_LIMIT)
        u = jnp.clip(u, -SWIGLU_LIMIT, SWIGLU_LIMIT)
        a = g * jax.nn.sigmoid(SWIGLU_ALPHA * g) * (u + 1.0)
        return a @ w_down[e] + b_down[e]

    ys = lax.map(expert_block, (xs, block_e)).reshape(P, D)
    ys = ys * row_w.astype(ys.dtype)[:, None]
    out = jax.ops.segment_sum(ys, row_tok, num_segments=N + 1)[:N]
    return out.reshape(B, S, D)


def setup_inputs(seed: int = 0) -> dict:
    key = jax.random.key(seed)
    ks = jax.random.split(key, 24)
    f32 = jnp.float32
    L = DEPTH

    def nrm(k, shape, scale):
        return jax.random.normal(k, shape, f32) * scale

    x = nrm(ks[0], (BATCH, SEQ, D_MODEL), 1.0)
    offsets = jax.random.randint(ks[1], (BATCH, 1), 0, MAX_POS_OFFSET, dtype=jnp.int32)
    positions = offsets + jnp.arange(SEQ, dtype=jnp.int32)[None, :]
    return {
        'x': x,
        'positions': positions,
        'norm_mix_g': 1.0 + nrm(ks[2], (L, D_MODEL), 0.02),
        'w_in': nrm(ks[3], (L, D_MODEL, IN_WIDTH), D_MODEL ** -0.5),
        'b_in': nrm(ks[4], (L, IN_WIDTH), 0.02),
        'attn_sinks': nrm(ks[5], (L, N_Q_HEADS), 0.5),
        'w_o_attn': nrm(ks[6], (L, ATTN_WIDTH, D_MODEL), ATTN_WIDTH ** -0.5),
        'b_o_attn': nrm(ks[7], (L, D_MODEL), 0.02),
        'w_pool_mix': nrm(ks[8], (L, len(POOL_WINDOWS), POOL_GROUP, POOL_GROUP), POOL_GROUP ** -0.5),
        'pool_scale': 1.0 + nrm(ks[9], (L, POOL_WIDTH), 0.02),
        'w_pool_up': nrm(ks[10], (L, POOL_WIDTH, D_MODEL), POOL_WIDTH ** -0.5),
        'w_out': nrm(ks[11], (L, D_MODEL, D_MODEL), D_MODEL ** -0.5),
        'norm_ffn_g': 1.0 + nrm(ks[12], (L, D_MODEL), 0.02),
        'w_router': nrm(ks[13], (L, D_MODEL, N_EXPERTS), D_MODEL ** -0.5),
        'b_router': nrm(ks[14], (L, N_EXPERTS), 0.01),
        'w_gate': nrm(ks[15], (L, N_EXPERTS, D_MODEL, D_FF), D_MODEL ** -0.5),
        'b_gate': nrm(ks[16], (L, N_EXPERTS, D_FF), 0.02),
        'w_up': nrm(ks[17], (L, N_EXPERTS, D_MODEL, D_FF), D_MODEL ** -0.5),
        'b_up': nrm(ks[18], (L, N_EXPERTS, D_FF), 0.02),
        'w_down': nrm(ks[19], (L, N_EXPERTS, D_FF, D_MODEL), D_FF ** -0.5),
        'b_down': nrm(ks[20], (L, N_EXPERTS, D_MODEL), 0.02),
        'norm_final_g': 1.0 + nrm(ks[21], (D_MODEL,), 0.02),
    }


def reference(x, positions, norm_mix_g, w_in, b_in, attn_sinks, w_o_attn, b_o_attn,
              w_pool_mix, pool_scale, w_pool_up, w_out, norm_ffn_g, w_router, b_router,
              w_gate, b_gate, w_up, b_up, w_down, b_down, norm_final_g):
    for l in range(DEPTH):
        h = rms_norm(x, norm_mix_g[l])
        x = x + token_mixer(h, positions, w_in[l], b_in[l], attn_sinks[l], w_o_attn[l], b_o_attn[l],
                            w_pool_mix[l], pool_scale[l], w_pool_up[l], w_out[l])
        h = rms_norm(x, norm_ffn_g[l])
        x = x + moe_ffn(h, w_router[l], b_router[l], w_gate[l], b_gate[l], w_up[l], b_up[l],
                        w_down[l], b_down[l])
    return rms_norm(x, norm_final_g)
```

```cpp
#include <hip/hip_runtime.h>
#include <cstdio>
#include <cstddef>

#ifndef MK_N_LAUNCHES
#define MK_N_LAUNCHES 1
#endif

#define GAS __attribute__((address_space(1)))
#define LAS __attribute__((address_space(3)))
typedef unsigned short bf16;
typedef unsigned v4u __attribute__((ext_vector_type(4)));
typedef unsigned v2u __attribute__((ext_vector_type(2)));
typedef float f32x4 __attribute__((ext_vector_type(4)));
typedef float f32x2 __attribute__((ext_vector_type(2)));
typedef short bf16x8 __attribute__((ext_vector_type(8)));
typedef int v8i __attribute__((ext_vector_type(8)));
typedef int v4i __attribute__((ext_vector_type(4)));
typedef GAS unsigned gu32;
#define RLX_AGENT __ATOMIC_RELAXED, __HIP_MEMORY_SCOPE_AGENT
#define LDS_WAIT() asm volatile("s_waitcnt lgkmcnt(0)" ::: "memory")
#define VM_WAIT() asm volatile("s_waitcnt vmcnt(0)" ::: "memory")

constexpr int NB = 8, SEQ = 4096, D = 1024, NTOK = NB * SEQ;
constexpr int HD = 64, NQH = 16, NKVH = 2;
constexpr int POOLW = 512;
constexpr int INW = 3840;
constexpr int NE = 32, DFF = 1024;
constexpr int HALF_TOK = NTOK / 2;
constexpr int LCAP = 16384;
constexpr float RMS_EPS = 1e-5f;
constexpr int NWAVES = 8;
constexpr int NPHASE = 9;
constexpr int N_LAUNCHES = MK_N_LAUNCHES;

constexpr size_t MiB = 1u << 20;
constexpr size_t WS_CTL = 0, CTL_ZERO_BYTES = 1 * MiB;
constexpr size_t WS_ROPE = 1 * MiB;
constexpr size_t WS_TOPW = 9 * MiB;
constexpr size_t WS_LTOK = 10 * MiB;
constexpr size_t WS_SSP = 14 * MiB;
constexpr size_t WS_WRHI = 18 * MiB;
constexpr size_t WS_WRLO = 18 * MiB + 65536;
constexpr size_t WS_WMIX = 18 * MiB + 2 * 65536;
constexpr size_t WS_WIN = 19 * MiB;
constexpr size_t WS_WO = 27 * MiB;
constexpr size_t WS_WUP = 29 * MiB;
constexpr size_t WS_WOUT = 30 * MiB;
constexpr size_t WS_WD8 = 32 * MiB;
constexpr size_t WS_RA = 64 * MiB;
constexpr size_t WS_RB = 128 * MiB;
constexpr size_t WS_Q = WS_RB, WS_K = WS_Q + 64 * MiB, WS_V = WS_K + 8 * MiB, WS_U = WS_V + 8 * MiB, WS_G = WS_U + 32 * MiB;
constexpr size_t WS_MIXED = 368 * MiB, WS_MERGED = 400 * MiB;
constexpr size_t WS_END = 528 * MiB;
constexpr size_t WS_A8 = 64 * MiB;
constexpr size_t WS_Y = 201 * MiB;
constexpr size_t WS_X1B = 329 * MiB;
constexpr size_t WS_H28 = 208 * MiB;
constexpr size_t WS_WGU8 = 464 * MiB;
static_assert(WS_Y + 128 * MiB <= WS_X1B && WS_A8 + 137 * MiB <= WS_Y && WS_X1B + 64 * MiB <= WS_MERGED && WS_MERGED + 64 * MiB <= WS_WGU8 && WS_WGU8 + 64 * MiB <= WS_END, "ws map");
static_assert(WS_G + 128 * MiB <= WS_MIXED, "ws map");
constexpr int CW_TMO = 0;
constexpr int CW_BAR = 4096;
constexpr int CW_GCNT = 8192;
constexpr int CW_CONV = 12288;

constexpr int RING_BYTES = 131072;
constexpr int TAB_OFF = RING_BYTES;
constexpr int T_CNT0 = 0, T_CNT1 = 32, T_PSTART = 64, T_NRBTOT = 100, T_LCNT = 128, T_LBASE = 192;
constexpr int RBMAP_OFF = RING_BYTES + 1024;
constexpr int MISC_OFF = RING_BYTES + 8192;
constexpr int LDS_BYTES = 147456;

__device__ __forceinline__ unsigned f2bf(float f) { unsigned u = __builtin_bit_cast(unsigned, f); return (u + 0x7fffu + ((u >> 16) & 1u)) >> 16; }
__device__ __forceinline__ unsigned pk2(float lo, float hi) { unsigned r; asm("v_cvt_pk_bf16_f32 %0, %1, %2" : "=v"(r) : "v"(lo), "v"(hi)); return r; }
__device__ __forceinline__ float bflo(unsigned w) { return __builtin_bit_cast(float, w << 16); }
__device__ __forceinline__ float bfhi(unsigned w) { return __builtin_bit_cast(float, w & 0xffff0000u); }
__device__ __forceinline__ float sigmoidf_(float x) { return __builtin_amdgcn_rcpf(1.0f + __builtin_amdgcn_exp2f(-1.4426950408889634f * x)); }

#define XB_TMO      128
#define XB_XCNT(j)  (256  + 64 * (j))
#define XB_XSUB(j)  (1280 + 64 * (j))
#define XB_XGEN(j)  (2304 + 64 * (j))
#define XB_TOP      3328
#define XB_TOPGEN   3392
#define XCD_BAR_WORDS 3456
#define XB_SPIN_CAP (1u << 18)
__device__ __forceinline__ unsigned xb_ld(unsigned* p)              { return __hip_atomic_load(p, __ATOMIC_RELAXED, __HIP_MEMORY_SCOPE_AGENT); }
__device__ __forceinline__ unsigned xb_add(unsigned* p, unsigned v) { return __hip_atomic_fetch_add(p, v, __ATOMIC_RELAXED, __HIP_MEMORY_SCOPE_AGENT); }
__device__ __forceinline__ unsigned xb_xcc_id() { return (unsigned)__builtin_amdgcn_s_getreg((3 << 11) | 20) & 0xFu; }
#define XB_SPIN(cond, bar) do { unsigned _sp = 0; while (cond) { __builtin_amdgcn_s_sleep(1); \
    if ((++_sp & 255u) == 0u) { if (xb_ld(&(bar)[XB_TMO])) break; if (_sp > XB_SPIN_CAP) { atomicAdd(&(bar)[XB_TMO], 1u); break; } } } } while (0)
struct XcdBarrier { unsigned* bar; unsigned x; volatile LAS unsigned* st; };
__device__ __forceinline__ XcdBarrier xcd_barrier_post(unsigned* bar, volatile LAS unsigned* st) {
    XcdBarrier b; b.bar = bar; b.x = xb_xcc_id(); b.st = st;
    if (threadIdx.x == 0) (void)xb_add(&bar[XB_XCNT(b.x)], 1u);
    return b;
}
__device__ __forceinline__ void xcd_barrier_complete(unsigned* bar, unsigned x, unsigned& nloc, unsigned& nx) {
    const unsigned G = gridDim.x * gridDim.y * gridDim.z;
    unsigned sum, cnt, mine, sp = 0u;
    for (;;) {
        sum = 0u; cnt = 0u; mine = 0u;
#pragma unroll
        for (unsigned j = 0; j < 16; ++j) { const unsigned c = xb_ld(&bar[XB_XCNT(j)]); sum += c; cnt += (c > 0u) ? 1u : 0u; mine = (j == x) ? c : mine; }
        if (sum == G) break;
        __builtin_amdgcn_s_sleep(1);
        if ((++sp & 255u) == 0u) { if (xb_ld(&bar[XB_TMO])) break; if (sp > XB_SPIN_CAP) { atomicAdd(&bar[XB_TMO], 1u); break; } }
    }
    nloc = mine > 0u ? mine : 1u; nx = cnt > 0u ? cnt : 1u;
}
__device__ __forceinline__ void xcd_barrier(const XcdBarrier& b) {
    asm volatile("s_waitcnt vmcnt(0)" ::: "memory");
    __syncthreads();
    if (threadIdx.x == 0) {
        unsigned* bar = b.bar;
        __builtin_amdgcn_s_waitcnt(0);
        unsigned nloc = b.st[0], nx = b.st[1];
        if (nloc == 0u) { xcd_barrier_complete(bar, b.x, nloc, nx); b.st[0] = nloc; b.st[1] = nx; }
        const unsigned old = xb_add(&bar[XB_XSUB(b.x)], 1u);
        const unsigned gen = old / nloc;
        if (old + 1u == (gen + 1u) * nloc) {
            __builtin_amdgcn_fence(__ATOMIC_RELEASE, "agent");
            asm volatile("s_waitcnt vmcnt(0)" ::: "memory");
            const unsigned og = xb_add(&bar[XB_TOP], 1u);
            const unsigned tg = og / nx;
            if (og + 1u == (tg + 1u) * nx) xb_add(&bar[XB_TOPGEN], 1u);
            else XB_SPIN(xb_ld(&bar[XB_TOPGEN]) == tg, bar);
            __builtin_amdgcn_fence(__ATOMIC_ACQUIRE, "agent");
            xb_add(&bar[XB_XGEN(b.x)], 1u);
            asm volatile("s_waitcnt vmcnt(0)" ::: "memory");
        } else {
            XB_SPIN(xb_ld(&bar[XB_XGEN(b.x)]) == gen, bar);
            __builtin_amdgcn_fence(__ATOMIC_ACQUIRE, "agent");
            asm volatile("s_waitcnt vmcnt(0)" ::: "memory");
        }
    }
    __syncthreads();
}

template <class F>
__device__ __forceinline__ void xcd_barrier_fill(const XcdBarrier& b, F&& fill) {
    asm volatile("s_waitcnt vmcnt(0)" ::: "memory");
    __syncthreads();
    if (threadIdx.x == 0) {
        unsigned* bar = b.bar;
        __builtin_amdgcn_s_waitcnt(0);
        unsigned nloc = b.st[0], nx = b.st[1];
        if (nloc == 0u) { xcd_barrier_complete(bar, b.x, nloc, nx); b.st[0] = nloc; b.st[1] = nx; }
        const unsigned old = xb_add(&bar[XB_XSUB(b.x)], 1u);
        const unsigned gen = old / nloc;
        b.st[2] = gen; b.st[3] = (old + 1u == (gen + 1u) * nloc) ? 1u : 0u;
    }
    __syncthreads();
    const unsigned gen = b.st[2], leader = b.st[3];
    if (!leader) { unsigned* xg = &b.bar[XB_XGEN(b.x)]; fill([&]() { return xb_ld(xg) != gen; }); }
    asm volatile("s_waitcnt vmcnt(0)" ::: "memory");
    __syncthreads();
    if (threadIdx.x == 0) {
        unsigned* bar = b.bar;
        if (leader) {
            const unsigned nx = b.st[1];
            __builtin_amdgcn_fence(__ATOMIC_RELEASE, "agent");
            asm volatile("s_waitcnt vmcnt(0)" ::: "memory");
            const unsigned og = xb_add(&bar[XB_TOP], 1u);
            const unsigned tg = og / nx;
            if (og + 1u == (tg + 1u) * nx) xb_add(&bar[XB_TOPGEN], 1u);
            else XB_SPIN(xb_ld(&bar[XB_TOPGEN]) == tg, bar);
            __builtin_amdgcn_fence(__ATOMIC_ACQUIRE, "agent");
            xb_add(&bar[XB_XGEN(b.x)], 1u);
            asm volatile("s_waitcnt vmcnt(0)" ::: "memory");
        } else {
            XB_SPIN(xb_ld(&bar[XB_XGEN(b.x)]) == gen, bar);
            __builtin_amdgcn_fence(__ATOMIC_ACQUIRE, "agent");
            asm volatile("s_waitcnt vmcnt(0)" ::: "memory");
        }
    }
    __syncthreads();
}

namespace pg8 {
constexpr int BM = 256, BK = 64, HALF = 128, HTB = HALF * BK * 2, NXCD = 8, WGM = 8;
__device__ __forceinline__ int lds_byte(int r, int c) { const int st = (r >> 4) * 2 + (c >> 5), rr = r & 15, cc = c & 31, ob = rr * 64 + cc * 2; return st * 1024 + (ob ^ (((ob >> 9) & 1) << 5)); }
__device__ __forceinline__ void stage_rc(int b, int& R, int& C) { const int st = b / 1024, sb = b % 1024, swz = sb ^ (((sb >> 9) & 1) << 5); R = (st >> 1) * 16 + swz / 64; C = (st & 1) * 32 + (swz % 64) / 2; }
__device__ __forceinline__ int perm32(int rho) { const int n = rho >> 4, i = rho & 15; return 8 * (i >> 2) + 4 * n + (i & 3); }

struct Unit { const char* A; const char* B; int nt; int ldb; int kind; int pm; int pn; int e; int r0; int aux; };
__device__ __forceinline__ bool tile_order(int nM, int nN, int G, int c, int i, int& pm, int& pn) {
    const int nwg = nM * nN; const long L = (long)i * G + c; if (L >= nwg) return false;
    int wgid = (int)L; { const int q = nwg / NXCD, r = nwg % NXCD, xcd = wgid % NXCD, off = wgid / NXCD; wgid = (xcd < r ? xcd * (q + 1) : r * (q + 1) + (xcd - r) * q) + off; }
    const int nig = WGM * nN, gid = wgid / nig, fm = gid * WGM, gsz = (nM - fm) < WGM ? (nM - fm) : WGM;
    pm = fm + ((wgid % nig) % gsz); pn = (wgid % nig) / gsz; return true;
}
__device__ __forceinline__ unsigned cvt_pk_bf16(float lo, float hi) { unsigned r; asm volatile("v_cvt_pk_bf16_f32 %0, %1, %2" : "=v"(r) : "v"(lo), "v"(hi)); return r; }

template <class P>
__device__ __forceinline__ void gemm_stream(LAS unsigned char* lds, const P& S) {
    int tid = threadIdx.x; asm volatile("" : "+v"(tid));
    const int wid = __builtin_amdgcn_readfirstlane(tid >> 6), lane = tid & 63, wr = wid >> 2, wc = wid & 3, fr = lane & 15, fq = lane >> 4;
    int Rb[2], C2[2];
#pragma unroll
    for (int i = 0; i < 2; ++i) { int R, C; stage_rc(tid * 16 + i * 8192, R, C); Rb[i] = P::PERM ? ((R & ~31) + perm32(R & 31)) : R; C2[i] = C * 2; }
    const size_t kstep = (size_t)(BK * 2);
    const unsigned ldsw = (unsigned)wid * 1024u;
    const int aoff = lds_byte(wr * 64 + fr, fq * 8), boff = lds_byte(wc * 32 + fr, fq * 8);
#define PG8_SA(b, h) (((b) * 2 + (h)) * HTB)
#define PG8_SB(b, h) ((4 + (b) * 2 + (h)) * HTB)
#define PG8_STAGE2(bufoff, gbase, v0, v1) do { \
        __builtin_amdgcn_global_load_lds((const unsigned*)((const char*)(gbase) + (v0)), (LAS unsigned*)(lds + (bufoff) + ldsw), 16, 0, 0); \
        __builtin_amdgcn_global_load_lds((const unsigned*)((const char*)(gbase) + (v1)), (LAS unsigned*)(lds + (bufoff) + ldsw + 8192), 16, 0, 0); } while (0)
#define PG8_LDA(dst, b, h) do { _Pragma("unroll") for (int m = 0; m < 4; ++m) { const v4i lo_ = *(const LAS v4i*)(lds + PG8_SA(b, h) + aoff + m * 2048), hi_ = *(const LAS v4i*)(lds + PG8_SA(b, h) + aoff + m * 2048 + 1024); dst[m] = __builtin_shufflevector(lo_, hi_, 0, 1, 2, 3, 4, 5, 6, 7); } } while (0)
#define PG8_LDB(dst, b, h) do { _Pragma("unroll") for (int n = 0; n < 2; ++n) { const v4i lo_ = *(const LAS v4i*)(lds + PG8_SB(b, h) + boff + n * 2048), hi_ = *(const LAS v4i*)(lds + PG8_SB(b, h) + boff + n * 2048 + 1024); dst[n] = __builtin_shufflevector(lo_, hi_, 0, 1, 2, 3, 4, 5, 6, 7); } } while (0)
#define PG8_LO(x) __builtin_bit_cast(bf16x8, __builtin_shufflevector((x), (x), 0, 1, 2, 3))
#define PG8_HI(x) __builtin_bit_cast(bf16x8, __builtin_shufflevector((x), (x), 4, 5, 6, 7))
#define PG8_MMA(ai, bj, At, Bt) do { __builtin_amdgcn_s_setprio(1); \
        if constexpr (P::FP8) { _Pragma("unroll") for (int m = 0; m < 4; ++m) _Pragma("unroll") for (int n = 0; n < 2; ++n) \
            asm volatile("v_mfma_f32_16x16x128_f8f6f4 %0, %1, %2, %0" : "+v"(acc[ai][bj][m][n]) : "v"(Bt[n]), "v"(At[m])); } \
        else { _Pragma("unroll") for (int m = 0; m < 4; ++m) _Pragma("unroll") for (int n = 0; n < 2; ++n) { \
            acc[ai][bj][m][n] = __builtin_amdgcn_mfma_f32_16x16x32_bf16(PG8_LO(Bt[n]), PG8_LO(At[m]), acc[ai][bj][m][n], 0, 0, 0); \
            acc[ai][bj][m][n] = __builtin_amdgcn_mfma_f32_16x16x32_bf16(PG8_HI(Bt[n]), PG8_HI(At[m]), acc[ai][bj][m][n], 0, 0, 0); } } \
        __builtin_amdgcn_s_setprio(0); } while (0)
#define PG8_WAIT_V(n) asm volatile("s_waitcnt vmcnt(" #n ")" ::: "memory")
#define PG8_WAIT_L(n) asm volatile("s_waitcnt lgkmcnt(" #n ")" ::: "memory")
#define PG8_BAR __builtin_amdgcn_s_barrier()
#define PG8_SCHED __builtin_amdgcn_sched_barrier(0)
    Unit cur, nxt; int ui = 0;
    if (!S.next(0, cur)) return;
    f32x4 acc[2][2][4][2];
#pragma unroll
    for (int a = 0; a < 2; ++a)
#pragma unroll
        for (int b = 0; b < 2; ++b)
#pragma unroll
            for (int m = 0; m < 4; ++m)
#pragma unroll
                for (int n = 0; n < 2; ++n) acc[a][b][m][n] = (f32x4){0.f, 0.f, 0.f, 0.f};
    v8i At[4], B0[2], B1[2];
    unsigned vA[2][2], vB[2];
    { int idx0[2][2] = {{0, 0}, {0, 0}}; S.lane_issue(cur, tid, idx0); S.lane_finish(cur, tid, idx0, vA); }
    vB[0] = (unsigned)(Rb[0] * cur.ldb + C2[0]); vB[1] = (unsigned)(Rb[1] * cur.ldb + C2[1]);
    const char* cA = cur.A; const char* cB = cur.B; size_t hB = (size_t)HALF * cur.ldb;
    PG8_STAGE2(PG8_SB(0, 0), cB, vB[0], vB[1]); PG8_STAGE2(PG8_SB(0, 1), cB + hB, vB[0], vB[1]); PG8_STAGE2(PG8_SA(0, 0), cA, vA[0][0], vA[0][1]); PG8_STAGE2(PG8_SA(0, 1), cA, vA[1][0], vA[1][1]);
    if (wr == 1) PG8_BAR;
    PG8_WAIT_V(2); PG8_BAR;
    PG8_STAGE2(PG8_SB(1, 0), cB + kstep, vB[0], vB[1]); PG8_STAGE2(PG8_SA(1, 0), cA + kstep, vA[0][0], vA[0][1]); PG8_STAGE2(PG8_SB(1, 1), cB + hB + kstep, vB[0], vB[1]);
    PG8_WAIT_V(6); PG8_BAR;
    for (;;) {
        bool has_next = false;
        const int nt = cur.nt;
        unsigned nvA[2][2], nvB[2];
        const char* nA = cA; const char* nB = cB; size_t nhB = hB;
#pragma unroll
        for (int h = 0; h < 2; ++h) { nvA[h][0] = vA[h][0]; nvA[h][1] = vA[h][1]; }
        nvB[0] = vB[0]; nvB[1] = vB[1];
        int nidx[2][2] = {{0, 0}, {0, 0}};
#pragma unroll 1
        for (int t = 0; t < nt; t += 2) {
            const bool last = (t == nt - 2);
            if (t == 0) { has_next = S.next(ui + 1, nxt); if (has_next) { if constexpr (!P::UNIFORM_A) S.lane_issue_asm(nxt, tid, nidx); } }
            if (last && has_next) { nA = nxt.A; nB = nxt.B; }
            const char* a1 = cA + (size_t)(t + 1) * kstep;
            const char* a2 = last ? nA : cA + (size_t)(t + 2) * kstep; const char* b2 = last ? nB : cB + (size_t)(t + 2) * kstep;
            const char* a3 = a2 + kstep; const char* b3 = b2 + kstep;
            const size_t h2 = (!P::UNIFORM_B && last) ? nhB : hB;
            const unsigned xa00 = (!P::UNIFORM_A && last) ? nvA[0][0] : vA[0][0], xa01 = (!P::UNIFORM_A && last) ? nvA[0][1] : vA[0][1], xa10 = (!P::UNIFORM_A && last) ? nvA[1][0] : vA[1][0], xa11 = (!P::UNIFORM_A && last) ? nvA[1][1] : vA[1][1];
            const unsigned xb0 = (!P::UNIFORM_B && last) ? nvB[0] : vB[0], xb1 = (!P::UNIFORM_B && last) ? nvB[1] : vB[1];
            PG8_LDB(B0, 0, 0); PG8_LDB(B1, 0, 1); PG8_SCHED; PG8_LDA(At, 0, 0); PG8_STAGE2(PG8_SA(1, 1), a1, vA[1][0], vA[1][1]);
            PG8_WAIT_V(8); PG8_WAIT_L(0); PG8_BAR; PG8_MMA(0, 0, At, B0); PG8_MMA(0, 1, At, B1); PG8_BAR; PG8_SCHED;
            PG8_LDA(At, 0, 1); PG8_STAGE2(PG8_SB(0, 0), b2, xb0, xb1); PG8_STAGE2(PG8_SB(0, 1), b2 + h2, xb0, xb1); PG8_STAGE2(PG8_SA(0, 0), a2, xa00, xa01);
            PG8_WAIT_V(8); PG8_WAIT_L(0); PG8_BAR; PG8_MMA(1, 0, At, B0); PG8_MMA(1, 1, At, B1); PG8_BAR; PG8_SCHED;
            PG8_LDB(B0, 1, 0); PG8_LDB(B1, 1, 1); PG8_SCHED; PG8_LDA(At, 1, 0); PG8_STAGE2(PG8_SA(0, 1), a2, xa10, xa11);
            PG8_WAIT_V(8); PG8_WAIT_L(0); PG8_BAR; PG8_MMA(0, 0, At, B0); PG8_MMA(0, 1, At, B1); PG8_BAR; PG8_SCHED;
            PG8_LDA(At, 1, 1); PG8_STAGE2(PG8_SB(1, 0), b3, xb0, xb1); PG8_STAGE2(PG8_SB(1, 1), b3 + h2, xb0, xb1); PG8_STAGE2(PG8_SA(1, 0), a3, xa00, xa01);
            PG8_WAIT_V(8); PG8_WAIT_L(0); PG8_BAR; PG8_MMA(1, 0, At, B0); PG8_MMA(1, 1, At, B1); PG8_BAR; PG8_SCHED;
            if (t == 0 && has_next) {
                if constexpr (!P::UNIFORM_A) { asm volatile("" : "+v"(nidx[0][0]), "+v"(nidx[0][1]), "+v"(nidx[1][0]), "+v"(nidx[1][1])); S.lane_finish(nxt, tid, nidx, nvA); }
                if constexpr (!P::UNIFORM_B) { nvB[0] = (unsigned)(Rb[0] * nxt.ldb + C2[0]); nvB[1] = (unsigned)(Rb[1] * nxt.ldb + C2[1]); nhB = (size_t)HALF * nxt.ldb; }
            }
        }
        if (wr == 0) PG8_BAR;
        if constexpr (P::FP8) asm volatile("s_nop 15\n\ts_nop 15" ::: "memory");
        S.epilogue(acc, cur, wr, wc, fr, fq);
        if (!has_next) break;
        if (!S.keep_acc(cur)) {
#pragma unroll
            for (int a = 0; a < 2; ++a)
#pragma unroll
                for (int b = 0; b < 2; ++b)
#pragma unroll
                    for (int m = 0; m < 4; ++m)
#pragma unroll
                        for (int n = 0; n < 2; ++n) acc[a][b][m][n] = (f32x4){0.f, 0.f, 0.f, 0.f};
        }
        cur = nxt; cA = nA; cB = nB; ++ui;
        if constexpr (!P::UNIFORM_A) {
#pragma unroll
            for (int h = 0; h < 2; ++h) { vA[h][0] = nvA[h][0]; vA[h][1] = nvA[h][1]; } }
        if constexpr (!P::UNIFORM_B) { vB[0] = nvB[0]; vB[1] = nvB[1]; hB = nhB; }
        if (wr == 1) PG8_BAR;
    }
    PG8_WAIT_V(0);
    PG8_BAR;
#undef PG8_SA
#undef PG8_SB
#undef PG8_STAGE2
#undef PG8_LDA
#undef PG8_LDB
#undef PG8_MMA
#undef PG8_LO
#undef PG8_HI
#undef PG8_WAIT_V
#undef PG8_WAIT_L
#undef PG8_BAR
#undef PG8_SCHED
}
}

struct Ptrs {
    const float* x; const int* positions; const float* norm_mix_g; const float* w_in; const float* b_in; const float* sinks; const float* w_o; const float* b_o;
    const float* w_pool_mix; const float* pool_scale; const float* w_pool_up; const float* w_out; const float* norm_ffn_g; const float* w_router; const float* b_router;
    const float* w_gate; const float* b_gate; const float* w_up; const float* b_up; const float* w_down; const float* b_down; const float* norm_final_g;
    float* out; unsigned char* ws;
};

struct PolP1 {
    static constexpr bool FP8 = true, UNIFORM_A = true, UNIFORM_B = true;
    static constexpr float SC = 1.0f / 64.0f;
    static constexpr bool PERM = true;
    const char* A; const char* B; const float* bias; const f32x2* rope; bf16 *Q, *K, *V, *U, *G; int G_, c;
    __device__ __forceinline__ bool next(int i, pg8::Unit& u) const {
        int pm, pn; if (!pg8::tile_order(NTOK / 256, INW / 256, G_, c, i, pm, pn)) return false;
        u.pm = pm; u.pn = pn; u.A = A + (size_t)pm * 256 * 1024; u.B = B + (size_t)pn * 256 * 1024; u.nt = 8; u.ldb = 1024; u.kind = 0; u.e = 0; u.r0 = 0; u.aux = 0; return true; }
    __device__ __forceinline__ void lane_issue(const pg8::Unit&, int, int (&)[2][2]) const {}
    __device__ __forceinline__ void lane_issue_asm(const pg8::Unit&, int, int (&)[2][2]) const {}
    __device__ __forceinline__ void lane_finish(const pg8::Unit&, int tid_, const int (&)[2][2], unsigned (&va)[2][2]) const {
        int R[2], C2[2];
#pragma unroll
        for (int i_ = 0; i_ < 2; ++i_) { int C_; pg8::stage_rc(tid_ * 16 + i_ * 8192, R[i_], C_); C2[i_] = C_ * 2; }
#pragma unroll
        for (int h = 0; h < 2; ++h) { va[h][0] = (unsigned)((R[0] + 128 * h) * 1024 + C2[0]); va[h][1] = (unsigned)((R[1] + 128 * h) * 1024 + C2[1]); } }
    __device__ __forceinline__ bool keep_acc(const pg8::Unit&) const { return false; }
    __device__ __forceinline__ void epilogue(f32x4 (&acc)[2][2][4][2], const pg8::Unit& u, int wr, int wc, int fr, int fq) const {
        const int row0 = u.pm * 256 + wr * 64 + fr;
        if (u.pn * 256 < 1152) {
            const int jq = ((32 * wc + 8 * fq) & 63) >> 3, d0 = 4 * jq;
#pragma unroll
            for (int bj = 0; bj < 2; ++bj) {
                const int zc = u.pn * 256 + bj * 128;
                if (zc >= 1152) {
                    const int cc = wc * 32 + 8 * fq; const f32x4 b0 = *(const f32x4*)(bias + zc + cc), b1 = *(const f32x4*)(bias + zc + cc + 4);
#pragma unroll
                    for (int ai = 0; ai < 2; ++ai)
#pragma unroll
                        for (int m = 0; m < 4; ++m) { const f32x4 v0 = acc[ai][bj][m][0] * SC + b0, v1 = acc[ai][bj][m][1] * SC + b1;
                            v4u w; w.x = pg8::cvt_pk_bf16(v0[0], v0[1]); w.y = pg8::cvt_pk_bf16(v0[2], v0[3]); w.z = pg8::cvt_pk_bf16(v1[0], v1[1]); w.w = pg8::cvt_pk_bf16(v1[2], v1[3]);
                            *(v4u*)(V + (size_t)(row0 + ai * 128 + m * 16) * 128 + cc) = w; }
                } else {
                    const bool isq = zc < 1024; bf16* dst = isq ? Q : K; const int ld = isq ? 1024 : 128; const int cc = (isq ? zc : 0) + wc * 32 + 8 * fq;
                    const int hb = (zc + wc * 32 + 8 * fq) & ~63;
                    const f32x4 b0 = *(const f32x4*)(bias + hb + d0), b1 = *(const f32x4*)(bias + hb + 32 + d0);
                    const float qs = isq ? 0.125f * 1.4426950408889634f : 1.0f;
#pragma unroll
                    for (int ai = 0; ai < 2; ++ai) {
                        f32x4 ra[4], rb[4];
#pragma unroll
                        for (int m = 0; m < 4; ++m) { const f32x4* rp = (const f32x4*)(rope + (size_t)(row0 + ai * 128 + m * 16) * 32 + d0); ra[m] = rp[0]; rb[m] = rp[1]; }
#pragma unroll
                        for (int m = 0; m < 4; ++m) {
                            const f32x4 x1 = acc[ai][bj][m][0] * SC + b0, x2 = acc[ai][bj][m][1] * SC + b1;
                            const float cs[4] = {ra[m].x, ra[m].z, rb[m].x, rb[m].z}, sn[4] = {ra[m].y, ra[m].w, rb[m].y, rb[m].w};
                            float o1[4], o2[4];
#pragma unroll
                            for (int j = 0; j < 4; ++j) { o1[j] = qs * (x1[j] * cs[j] - x2[j] * sn[j]); o2[j] = qs * (x2[j] * cs[j] + x1[j] * sn[j]); }
                            v4u w; w.x = pg8::cvt_pk_bf16(o1[0], o1[1]); w.y = pg8::cvt_pk_bf16(o1[2], o1[3]); w.z = pg8::cvt_pk_bf16(o2[0], o2[1]); w.w = pg8::cvt_pk_bf16(o2[2], o2[3]);
                            *(v4u*)(dst + (size_t)(row0 + ai * 128 + m * 16) * ld + cc) = w; }
                    }
                }
            }
            return;
        }
        if (u.pn * 256 >= 1792) {
            const int c = ((u.pn * 256 - 1792) >> 8) * 128 + wc * 32 + 8 * fq;
            const float* bp = bias + 1792 + c;
            const f32x4 b00 = *(const f32x4*)bp, b01 = *(const f32x4*)(bp + 4), b10 = *(const f32x4*)(bp + 1024), b11 = *(const f32x4*)(bp + 1028);
            const float nl = -1.4426950408889634f;
#pragma unroll
            for (int ai = 0; ai < 2; ++ai)
#pragma unroll
                for (int m = 0; m < 4; ++m) {
                    const f32x4 z0[2] = {acc[ai][0][m][0] * SC + b00, acc[ai][0][m][1] * SC + b01}, z1[2] = {acc[ai][1][m][0] * SC + b10, acc[ai][1][m][1] * SC + b11};
                    float rho[8], g1v[8];
#pragma unroll
                    for (int h = 0; h < 2; ++h)
#pragma unroll
                        for (int j = 0; j < 4; ++j) { const float d0 = 1.0f + __builtin_amdgcn_exp2f(nl * z0[h][j]), d1 = 1.0f + __builtin_amdgcn_exp2f(nl * z1[h][j]);
                            g1v[4 * h + j] = __builtin_amdgcn_rcpf(d1); rho[4 * h + j] = d1 * __builtin_amdgcn_rcpf(d0); }
                    bf16* gp = G + (size_t)(row0 + ai * 128 + m * 16) * 2048 + c;
                    v4u w; w.x = pg8::cvt_pk_bf16(rho[0], rho[1]); w.y = pg8::cvt_pk_bf16(rho[2], rho[3]); w.z = pg8::cvt_pk_bf16(rho[4], rho[5]); w.w = pg8::cvt_pk_bf16(rho[6], rho[7]);
                    *(v4u*)gp = w;
                    w.x = pg8::cvt_pk_bf16(g1v[0], g1v[1]); w.y = pg8::cvt_pk_bf16(g1v[2], g1v[3]); w.z = pg8::cvt_pk_bf16(g1v[4], g1v[5]); w.w = pg8::cvt_pk_bf16(g1v[6], g1v[7]);
                    *(v4u*)(gp + 1024) = w; }
            return;
        }
#pragma unroll
        for (int bj = 0; bj < 2; ++bj) {
            const int zc = u.pn * 256 + bj * 128; const int cc = zc - 1280 + wc * 32 + 8 * fq;
            const float* bp = bias + zc + wc * 32 + 8 * fq; const f32x4 b0 = *(const f32x4*)bp, b1 = *(const f32x4*)(bp + 4);
#pragma unroll
            for (int ai = 0; ai < 2; ++ai)
#pragma unroll
                for (int m = 0; m < 4; ++m) {
                    const f32x4 v0 = acc[ai][bj][m][0] * SC + b0, v1 = acc[ai][bj][m][1] * SC + b1;
                    v4u w; w.x = pg8::cvt_pk_bf16(v0[0], v0[1]); w.y = pg8::cvt_pk_bf16(v0[2], v0[3]); w.z = pg8::cvt_pk_bf16(v1[0], v1[1]); w.w = pg8::cvt_pk_bf16(v1[2], v1[3]);
                    *(v4u*)(U + (size_t)(row0 + ai * 128 + m * 16) * 512 + cc) = w; }
        }
    }
};

struct PolP3 {
    static constexpr bool FP8 = false, UNIFORM_A = false, UNIFORM_B = false;
    static constexpr bool PERM = true;
    const char *A0, *B0, *A1, *B1; const float* bo; const bf16* G; bf16* O; int G_, c;
    __device__ __forceinline__ bool next(int i, pg8::Unit& u) const {
        int pm, pn; if (!pg8::tile_order(NTOK / 256, D / 256, G_, c, i >> 1, pm, pn)) return false;
        u.pm = pm; u.pn = pn; u.kind = i & 1; u.e = 0; u.r0 = 0; u.aux = 0;
        if (u.kind == 0) { u.A = A0 + (size_t)pm * 256 * 2048; u.B = B0 + (size_t)pn * 256 * 2048; u.nt = 16; u.ldb = 2048; }
        else { u.A = A1 + (size_t)pm * 256 * 1024; u.B = B1 + (size_t)pn * 256 * 1024; u.nt = 8; u.ldb = 1024; }
        return true; }
    __device__ __forceinline__ void lane_issue(const pg8::Unit&, int, int (&)[2][2]) const {}
    __device__ __forceinline__ void lane_issue_asm(const pg8::Unit&, int, int (&)[2][2]) const {}
    __device__ __forceinline__ void lane_finish(const pg8::Unit& u, int tid_, const int (&)[2][2], unsigned (&va)[2][2]) const {
        int R[2], C2[2];
#pragma unroll
        for (int i_ = 0; i_ < 2; ++i_) { int C_; pg8::stage_rc(tid_ * 16 + i_ * 8192, R[i_], C_); C2[i_] = C_ * 2; }
        const int lda = u.kind == 0 ? 2048 : 1024;
#pragma unroll
        for (int h = 0; h < 2; ++h) { va[h][0] = (unsigned)((R[0] + 128 * h) * lda + C2[0]); va[h][1] = (unsigned)((R[1] + 128 * h) * lda + C2[1]); } }
    __device__ __forceinline__ bool keep_acc(const pg8::Unit& u) const { return u.kind == 0; }
    __device__ __forceinline__ void epilogue(f32x4 (&acc)[2][2][4][2], const pg8::Unit& u, int wr, int wc, int fr, int fq) const {
        const int row0 = u.pm * 256 + wr * 64 + fr;
        const int cc0 = u.pn * 256 + wc * 32 + 8 * fq;
        if (u.kind == 0) {
            f32x4 bb[2][2];
#pragma unroll
            for (int bj = 0; bj < 2; ++bj) { bb[bj][0] = *(const f32x4*)(bo + cc0 + bj * 128); bb[bj][1] = *(const f32x4*)(bo + cc0 + bj * 128 + 4); }
#pragma unroll
            for (int ai = 0; ai < 2; ++ai) {
                v4u g0[4][2];
#pragma unroll
                for (int m = 0; m < 4; ++m)
#pragma unroll
                    for (int bj = 0; bj < 2; ++bj) g0[m][bj] = *(const v4u*)(G + (size_t)(row0 + ai * 128 + m * 16) * 2048 + cc0 + bj * 128);
#pragma unroll
                for (int m = 0; m < 4; ++m)
#pragma unroll
                    for (int bj = 0; bj < 2; ++bj) {
                        const v4u a0 = g0[m][bj];
                        f32x4 v0 = acc[ai][bj][m][0] + bb[bj][0], v1 = acc[ai][bj][m][1] + bb[bj][1];
                        v0[0] *= bflo(a0.x); v0[1] *= bfhi(a0.x); v0[2] *= bflo(a0.y); v0[3] *= bfhi(a0.y);
                        v1[0] *= bflo(a0.z); v1[1] *= bfhi(a0.z); v1[2] *= bflo(a0.w); v1[3] *= bfhi(a0.w);
                        acc[ai][bj][m][0] = v0; acc[ai][bj][m][1] = v1; }
            }
        } else {
            v4u g1[2][4][2];
#pragma unroll
            for (int ai = 0; ai < 2; ++ai)
#pragma unroll
                for (int m = 0; m < 4; ++m)
#pragma unroll
                    for (int bj = 0; bj < 2; ++bj) g1[ai][m][bj] = *(const v4u*)(G + (size_t)(row0 + ai * 128 + m * 16) * 2048 + 1024 + cc0 + bj * 128);
#pragma unroll
            for (int ai = 0; ai < 2; ++ai)
#pragma unroll
                for (int m = 0; m < 4; ++m)
#pragma unroll
                    for (int bj = 0; bj < 2; ++bj) {
                        const v4u a1 = g1[ai][m][bj];
                        const f32x4 v0 = acc[ai][bj][m][0], v1 = acc[ai][bj][m][1];
                        v4u w; w.x = pg8::cvt_pk_bf16(v0[0] * bflo(a1.x), v0[1] * bfhi(a1.x)); w.y = pg8::cvt_pk_bf16(v0[2] * bflo(a1.y), v0[3] * bfhi(a1.y));
                        w.z = pg8::cvt_pk_bf16(v1[0] * bflo(a1.z), v1[1] * bfhi(a1.z)); w.w = pg8::cvt_pk_bf16(v1[2] * bflo(a1.w), v1[3] * bfhi(a1.w));
                        *(v4u*)(O + (size_t)(row0 + ai * 128 + m * 16) * 1024 + cc0 + bj * 128) = w; }
        }
    }
};

struct PolP4 {
    static constexpr bool FP8 = false, UNIFORM_A = true, UNIFORM_B = true;
    static constexpr bool PERM = true;
    const char* A; const char* B; const float* x; bf16* out; float* ssp; int G_, c;
    __device__ __forceinline__ bool next(int i, pg8::Unit& u) const {
        int pm, pn; if (!pg8::tile_order(NTOK / 256, D / 256, G_, c, i, pm, pn)) return false;
        u.pm = pm; u.pn = pn; u.A = A + (size_t)pm * 256 * 2048; u.B = B + (size_t)pn * 256 * 2048; u.nt = 16; u.ldb = 2048; u.kind = 0; u.e = 0; u.r0 = 0; u.aux = 0; return true; }
    __device__ __forceinline__ void lane_issue(const pg8::Unit&, int, int (&)[2][2]) const {}
    __device__ __forceinline__ void lane_issue_asm(const pg8::Unit&, int, int (&)[2][2]) const {}
    __device__ __forceinline__ void lane_finish(const pg8::Unit&, int tid_, const int (&)[2][2], unsigned (&va)[2][2]) const {
        int R[2], C2[2];
#pragma unroll
        for (int i_ = 0; i_ < 2; ++i_) { int C_; pg8::stage_rc(tid_ * 16 + i_ * 8192, R[i_], C_); C2[i_] = C_ * 2; }
#pragma unroll
        for (int h = 0; h < 2; ++h) { va[h][0] = (unsigned)((R[0] + 128 * h) * 2048 + C2[0]); va[h][1] = (unsigned)((R[1] + 128 * h) * 2048 + C2[1]); } }
    __device__ __forceinline__ bool keep_acc(const pg8::Unit&) const { return false; }
    __device__ __forceinline__ void epilogue(f32x4 (&acc)[2][2][4][2], const pg8::Unit& u, int wr, int wc, int fr, int fq) const {
        const int row0 = u.pm * 256 + wr * 64 + fr, col0 = u.pn * 256 + wc * 32 + 8 * fq;
#pragma unroll
        for (int ai = 0; ai < 2; ++ai) {
            f32x4 xv[4][2][2];
#pragma unroll
            for (int m = 0; m < 4; ++m)
#pragma unroll
                for (int bj = 0; bj < 2; ++bj)
#pragma unroll
                    for (int n = 0; n < 2; ++n) xv[m][bj][n] = *(const f32x4*)(x + (size_t)(row0 + ai * 128 + m * 16) * D + col0 + bj * 128 + n * 4);
#pragma unroll
            for (int m = 0; m < 4; ++m) { const size_t off = (size_t)(row0 + ai * 128 + m * 16) * D + col0; float ss = 0.f;
#pragma unroll
                for (int bj = 0; bj < 2; ++bj) { const f32x4 o0 = acc[ai][bj][m][0] + xv[m][bj][0], o1 = acc[ai][bj][m][1] + xv[m][bj][1];
                    ss += ((o0[0] * o0[0] + o0[1] * o0[1]) + (o0[2] * o0[2] + o0[3] * o0[3])) + ((o1[0] * o1[0] + o1[1] * o1[1]) + (o1[2] * o1[2] + o1[3] * o1[3]));
                    v4u w; w.x = pg8::cvt_pk_bf16(o0[0], o0[1]); w.y = pg8::cvt_pk_bf16(o0[2], o0[3]); w.z = pg8::cvt_pk_bf16(o1[0], o1[1]); w.w = pg8::cvt_pk_bf16(o1[2], o1[3]);
                    *(v4u*)(out + off + bj * 128) = w; }
                ss += __shfl_xor(ss, 16); ss += __shfl_xor(ss, 32);
                if (fq == 0) ssp[(size_t)(row0 + ai * 128 + m * 16) * 16 + u.pn * 4 + wc] = ss; }
        }
    }
};

__device__ __forceinline__ unsigned pk4_fp8(float a, float b, float c, float d) { int w = __builtin_amdgcn_cvt_pk_fp8_f32(a, b, 0, false); w = __builtin_amdgcn_cvt_pk_fp8_f32(c, d, w, true); return (unsigned)w; }
struct PolP7 {
    static constexpr bool FP8 = true, UNIFORM_A = false, UNIFORM_B = true;
    static constexpr bool PERM = true;
    const char* H2; const char* W; const int* ltok; const float* bg; const float* bu; unsigned char* a; const LAS int* tab; const LAS unsigned* rbmap; int G_, c;
    __device__ __forceinline__ bool next(int i, pg8::Unit& u) const {
        const int nrb = __builtin_amdgcn_readfirstlane(tab[T_NRBTOT]); int pm, pn; if (!pg8::tile_order(nrb, 8, G_, c, i, pm, pn)) return false;
        const unsigned m = (unsigned)__builtin_amdgcn_readfirstlane((int)rbmap[pm]); const int e = (int)(m >> 16), rb = (int)(m & 0xffffu);
        u.pm = pm; u.pn = pn; u.e = e; u.r0 = rb * 256; u.A = H2; u.B = W + ((size_t)e * 2048 + (size_t)pn * 256) * 1024; u.nt = 8; u.ldb = 1024; u.kind = 0; u.aux = 0; return true; }
    __device__ __forceinline__ void lane_issue(const pg8::Unit& u, int tid_, int (&idx)[2][2]) const {
        int R[2];
#pragma unroll
        for (int i_ = 0; i_ < 2; ++i_) { int C_; pg8::stage_rc(tid_ * 16 + i_ * 8192, R[i_], C_); }
        const int e = u.e, c0 = tab[T_CNT0 + e], c1 = tab[T_CNT1 + e];
#pragma unroll
        for (int h = 0; h < 2; ++h)
#pragma unroll
            for (int i = 0; i < 2; ++i) { const int rr = u.r0 + R[i] + 128 * h; const bool in0 = rr < c0, in1 = rr < c0 + c1;
                int li = in0 ? e * LCAP + rr : (NE + e) * LCAP + (rr - c0); li = in1 ? li : e * LCAP; idx[h][i] = ltok[li]; } }
    __device__ __forceinline__ void lane_issue_asm(const pg8::Unit& u, int tid_, int (&idx)[2][2]) const {
        int R[2];
#pragma unroll
        for (int i_ = 0; i_ < 2; ++i_) { int C_; pg8::stage_rc(tid_ * 16 + i_ * 8192, R[i_], C_); }
        const int e = u.e, c0 = tab[T_CNT0 + e], c1 = tab[T_CNT1 + e];
#pragma unroll
        for (int h = 0; h < 2; ++h)
#pragma unroll
            for (int i = 0; i < 2; ++i) { const int rr = u.r0 + R[i] + 128 * h; const bool in0 = rr < c0, in1 = rr < c0 + c1;
                int li = in0 ? e * LCAP + rr : (NE + e) * LCAP + (rr - c0); li = in1 ? li : e * LCAP; const unsigned boff = (unsigned)li * 4u;
                asm volatile("global_load_dword %0, %1, %2" : "=&v"(idx[h][i]) : "v"(boff), "s"(ltok) : "memory"); } }
    __device__ __forceinline__ void lane_finish(const pg8::Unit& u, int tid_, const int (&idx)[2][2], unsigned (&va)[2][2]) const {
        int R[2], C2[2];
#pragma unroll
        for (int i_ = 0; i_ < 2; ++i_) { int C_; pg8::stage_rc(tid_ * 16 + i_ * 8192, R[i_], C_); C2[i_] = C_ * 2; }
        const int e = u.e, c0 = tab[T_CNT0 + e], c1 = tab[T_CNT1 + e];
#pragma unroll
        for (int h = 0; h < 2; ++h)
#pragma unroll
            for (int i = 0; i < 2; ++i) { const int rr = u.r0 + R[i] + 128 * h; const bool in1 = rr < c0 + c1; va[h][i] = (unsigned)((in1 ? (idx[h][i] >> 2) : 0) * 1024 + C2[i]); } }
    __device__ __forceinline__ bool keep_acc(const pg8::Unit&) const { return false; }
    __device__ __forceinline__ void epilogue(f32x4 (&acc)[2][2][4][2], const pg8::Unit& u, int wr, int wc, int fr, int fq) const {
        const int e = u.e, ps = tab[T_PSTART + e];
        const int ff = u.pn * 128 + wc * 32 + 8 * fq;
        const f32x4 g0 = *(const f32x4*)(bg + e * DFF + ff), g1 = *(const f32x4*)(bg + e * DFF + ff + 4), u0 = *(const f32x4*)(bu + e * DFF + ff), u1 = *(const f32x4*)(bu + e * DFF + ff + 4);
        const f32x2 scg = {1.0f / 64.0f, 1.0f / 64.0f}, scu = {4.0f / 64.0f, 4.0f / 64.0f}, kk = {-1.702f * 1.4426950408889634f, -1.702f * 1.4426950408889634f}, one = {1.0f, 1.0f};
        f32x2 bgp[4], bup[4];
        bgp[0] = (f32x2){g0[0], g0[1]}; bgp[1] = (f32x2){g0[2], g0[3]}; bgp[2] = (f32x2){g1[0], g1[1]}; bgp[3] = (f32x2){g1[2], g1[3]};
        bup[0] = (f32x2){4.f * u0[0] + 4.f, 4.f * u0[1] + 4.f}; bup[1] = (f32x2){4.f * u0[2] + 4.f, 4.f * u0[3] + 4.f}; bup[2] = (f32x2){4.f * u1[0] + 4.f, 4.f * u1[1] + 4.f}; bup[3] = (f32x2){4.f * u1[2] + 4.f, 4.f * u1[3] + 4.f};
#pragma unroll
        for (int ai = 0; ai < 2; ++ai)
#pragma unroll
            for (int mp = 0; mp < 2; ++mp) {
                v2u wq[2];
#pragma unroll
                for (int mm = 0; mm < 2; ++mm) { const int m = 2 * mp + mm;
                    f32x2 o[4];
#pragma unroll
                    for (int q = 0; q < 4; ++q) {
                        const f32x4 ga = acc[ai][0][m][q >> 1], ua = acc[ai][1][m][q >> 1];
                        f32x2 g = (q & 1) ? (f32x2){ga[2], ga[3]} : (f32x2){ga[0], ga[1]}, uu = (q & 1) ? (f32x2){ua[2], ua[3]} : (f32x2){ua[0], ua[1]};
                        g = g * scg + bgp[q]; uu = uu * scu + bup[q];
                        g.x = fminf(g.x, 7.0f); g.y = fminf(g.y, 7.0f);
                        uu.x = __builtin_amdgcn_fmed3f(uu.x, -24.0f, 32.0f); uu.y = __builtin_amdgcn_fmed3f(uu.y, -24.0f, 32.0f);
                        f32x2 t = g * kk; t.x = __builtin_amdgcn_exp2f(t.x); t.y = __builtin_amdgcn_exp2f(t.y);
                        t = t + one; t.x = __builtin_amdgcn_rcpf(t.x); t.y = __builtin_amdgcn_rcpf(t.y);
                        o[q] = (g * t) * uu; }
                    wq[mm].x = pk4_fp8(o[0].x, o[0].y, o[1].x, o[1].y); wq[mm].y = pk4_fp8(o[2].x, o[2].y, o[3].x, o[3].y); }
                const v2u r0 = __builtin_amdgcn_permlane16_swap(wq[0].x, wq[1].x, false, false), r1 = __builtin_amdgcn_permlane16_swap(wq[0].y, wq[1].y, false, false);
                const int rr = u.r0 + ai * 128 + wr * 64 + (2 * mp + (fq & 1)) * 16 + fr;
                *(v4u*)(a + (size_t)(ps + rr) * DFF + (ff - 8 * (fq & 1))) = (v4u){r0.x, r1.x, r0.y, r1.y}; }
    }
};

struct PolP8 {
    static constexpr bool FP8 = true, UNIFORM_A = true, UNIFORM_B = true;
    static constexpr bool PERM = true;
    const char* Aa; const char* W; const int* ltok; const float* bd; unsigned char* Y; const LAS int* tab; const LAS unsigned* rbmap; int G_, c;
    __device__ __forceinline__ bool next(int i, pg8::Unit& u) const {
        const int nrb = __builtin_amdgcn_readfirstlane(tab[T_NRBTOT]); int pm, pn; if (!pg8::tile_order(nrb, 4, G_, c, i, pm, pn)) return false;
        const unsigned m = (unsigned)__builtin_amdgcn_readfirstlane((int)rbmap[pm]); const int e = (int)(m >> 16), rb = (int)(m & 0xffffu);
        const int arow = __builtin_amdgcn_readfirstlane(tab[T_PSTART + e]) + rb * 256;
        u.pm = pm; u.pn = pn; u.e = e; u.r0 = rb * 256; u.A = Aa + (size_t)arow * 1024; u.B = W + ((size_t)e * 1024 + (size_t)pn * 256) * 1024; u.nt = 8; u.ldb = 1024; u.kind = 0; u.aux = 0; return true; }
    __device__ __forceinline__ void lane_issue(const pg8::Unit&, int, int (&)[2][2]) const {}
    __device__ __forceinline__ void lane_issue_asm(const pg8::Unit&, int, int (&)[2][2]) const {}
    __device__ __forceinline__ void lane_finish(const pg8::Unit&, int tid_, const int (&)[2][2], unsigned (&va)[2][2]) const {
        int R[2], C2[2];
#pragma unroll
        for (int i_ = 0; i_ < 2; ++i_) { int C_; pg8::stage_rc(tid_ * 16 + i_ * 8192, R[i_], C_); C2[i_] = C_ * 2; }
#pragma unroll
        for (int h = 0; h < 2; ++h) { va[h][0] = (unsigned)((R[0] + 128 * h) * 1024 + C2[0]); va[h][1] = (unsigned)((R[1] + 128 * h) * 1024 + C2[1]); } }
    __device__ __forceinline__ bool keep_acc(const pg8::Unit&) const { return false; }
    __device__ __forceinline__ void epilogue(f32x4 (&acc)[2][2][4][2], const pg8::Unit& u, int wr, int wc, int fr, int fq) const {
        const int e = u.e, c0 = tab[T_CNT0 + e], c1 = tab[T_CNT1 + e];
        const int cc0 = u.pn * 256 + wc * 32 + 8 * fq;
        f32x4 bb[2][2]; int dstp[2][2];
#pragma unroll
        for (int bj = 0; bj < 2; ++bj) { bb[bj][0] = *(const f32x4*)(bd + e * D + cc0 + bj * 128); bb[bj][1] = *(const f32x4*)(bd + e * D + cc0 + bj * 128 + 4); }
#pragma unroll
        for (int ai = 0; ai < 2; ++ai)
#pragma unroll
            for (int mp = 0; mp < 2; ++mp) { const int rr = u.r0 + ai * 128 + wr * 64 + (2 * mp + (fq & 1)) * 16 + fr; const bool in0 = rr < c0, in1 = rr < c0 + c1;
                int li = in0 ? e * LCAP + rr : (NE + e) * LCAP + (rr - c0); li = in1 ? li : e * LCAP; dstp[ai][mp] = ltok[li]; }
        const float sc = 8.0f / 256.0f;
#pragma unroll
        for (int bj = 0; bj < 2; ++bj) { bb[bj][0] *= 8.0f; bb[bj][1] *= 8.0f; }
#pragma unroll
        for (int ai = 0; ai < 2; ++ai)
#pragma unroll
            for (int mp = 0; mp < 2; ++mp) {
                const int msel = 2 * mp + (fq & 1);
                const int rr = u.r0 + ai * 128 + wr * 64 + msel * 16 + fr;
                const int d_ = dstp[ai][mp];
#pragma unroll
                for (int bj = 0; bj < 2; ++bj) {
                    v2u wq[2];
#pragma unroll
                    for (int mm = 0; mm < 2; ++mm) { const int m = 2 * mp + mm;
                        const f32x4 v0 = acc[ai][bj][m][0] * sc + bb[bj][0], v1 = acc[ai][bj][m][1] * sc + bb[bj][1];
                        wq[mm].x = pk4_fp8(v0[0], v0[1], v0[2], v0[3]); wq[mm].y = pk4_fp8(v1[0], v1[1], v1[2], v1[3]); }
                    const v2u r0 = __builtin_amdgcn_permlane16_swap(wq[0].x, wq[1].x, false, false), r1 = __builtin_amdgcn_permlane16_swap(wq[0].y, wq[1].y, false, false);
                    if (rr < c0 + c1) *(v4u*)(Y + (size_t)d_ * D + cc0 + bj * 128 - 8 * (fq & 1)) = (v4u){r0.x, r1.x, r0.y, r1.y}; }
            }
    }
};

__device__ __forceinline__ float wave_sum(float v) {
#pragma unroll
    for (int o = 1; o < 64; o <<= 1) v += __shfl_xor(v, o);
    return v;
}
__device__ __forceinline__ void transpose_item(const float* W, int K, int N, bf16* WT, int k0, int n0, int drow0, LAS float* scr, int lane) {
#pragma unroll 8
    for (int i = 0; i < 32; ++i) { const int kk = 2 * i + (lane >> 5); scr[kk * 33 + (lane & 31)] = W[(size_t)(k0 + kk) * N + n0 + (lane & 31)]; }
    LDS_WAIT(); asm volatile("" ::: "memory");
    const int c = lane & 7;
#pragma unroll
    for (int j = 0; j < 4; ++j) { const int n = (lane >> 3) + 8 * j; const LAS float* s = scr + (8 * c) * 33 + n;
        v4u o; o.x = pk2(s[0 * 33], s[1 * 33]); o.y = pk2(s[2 * 33], s[3 * 33]); o.z = pk2(s[4 * 33], s[5 * 33]); o.w = pk2(s[6 * 33], s[7 * 33]);
        *(v4u*)(WT + (size_t)(drow0 + n) * K + k0 + 8 * c) = o; }
    LDS_WAIT(); asm volatile("" ::: "memory");
}
__device__ __forceinline__ void transpose_item8(const float* W, int K, int N, unsigned char* WT, int k0, int n0, int drow0, float scale, LAS float* scr, int lane) {
#pragma unroll 8
    for (int i = 0; i < 32; ++i) { const int kk = 2 * i + (lane >> 5); scr[kk * 33 + (lane & 31)] = W[(size_t)(k0 + kk) * N + n0 + (lane & 31)]; }
    LDS_WAIT(); asm volatile("" ::: "memory");
    const int c = lane & 7;
#pragma unroll
    for (int j = 0; j < 4; ++j) { const int n = (lane >> 3) + 8 * j; const LAS float* s = scr + (8 * c) * 33 + n;
        v2u o; o.x = pk4_fp8(s[0 * 33] * scale, s[1 * 33] * scale, s[2 * 33] * scale, s[3 * 33] * scale); o.y = pk4_fp8(s[4 * 33] * scale, s[5 * 33] * scale, s[6 * 33] * scale, s[7 * 33] * scale);
        *(v2u*)(WT + (size_t)(drow0 + n) * K + k0 + 8 * c) = o; }
    LDS_WAIT(); asm volatile("" ::: "memory");
}
__device__ __forceinline__ int qk_perm_d(int p) { const int j = (p >> 3) & 7, i = p & 7; return (p & ~63) + 4 * j + (i & 3) + 32 * (i >> 2); }
__device__ __forceinline__ void transpose_item_qk(const float* W, int K, int N, bf16* WT, int k0, int n0, LAS float* scr, int lane) {
    const int p = n0 + (lane & 31); const int srcc = (n0 < 1152) ? qk_perm_d(p) : p;
#pragma unroll 8
    for (int i = 0; i < 32; ++i) { const int kk = 2 * i + (lane >> 5); scr[kk * 33 + (lane & 31)] = W[(size_t)(k0 + kk) * N + srcc]; }
    LDS_WAIT(); asm volatile("" ::: "memory");
    const int c = lane & 7;
#pragma unroll
    for (int j = 0; j < 4; ++j) { const int n = (lane >> 3) + 8 * j; const LAS float* s = scr + (8 * c) * 33 + n;
        v4u o; o.x = pk2(s[0 * 33], s[1 * 33]); o.y = pk2(s[2 * 33], s[3 * 33]); o.z = pk2(s[4 * 33], s[5 * 33]); o.w = pk2(s[6 * 33], s[7 * 33]);
        *(v4u*)(WT + (size_t)(n0 + n) * K + k0 + 8 * c) = o; }
    LDS_WAIT(); asm volatile("" ::: "memory");
}
__device__ __forceinline__ void transpose_item_qk8(const float* W, int K, int N, unsigned char* WT, int k0, int n0, LAS float* scr, int lane) {
    const int p = n0 + (lane & 31); int srcc = (n0 < 1152) ? qk_perm_d(p) : p;
    if (n0 >= 1792) { const int q = p - 1792; srcc = 1792 + ((q >> 7) & 1) * 1024 + (q >> 8) * 128 + (q & 127); }
#pragma unroll 8
    for (int i = 0; i < 32; ++i) { const int kk = 2 * i + (lane >> 5); scr[kk * 33 + (lane & 31)] = W[(size_t)(k0 + kk) * N + srcc]; }
    LDS_WAIT(); asm volatile("" ::: "memory");
    const int c = lane & 7;
#pragma unroll
    for (int j = 0; j < 4; ++j) { const int n = (lane >> 3) + 8 * j; const LAS float* s = scr + (8 * c) * 33 + n;
        v2u o; o.x = pk4_fp8(s[0 * 33] * 64.f, s[1 * 33] * 64.f, s[2 * 33] * 64.f, s[3 * 33] * 64.f); o.y = pk4_fp8(s[4 * 33] * 64.f, s[5 * 33] * 64.f, s[6 * 33] * 64.f, s[7 * 33] * 64.f);
        *(v2u*)(WT + (size_t)(n0 + n) * K + k0 + 8 * c) = o; }
    LDS_WAIT(); asm volatile("" ::: "memory");
}
__device__ __forceinline__ void transpose_item8w(const float* W, int N, unsigned char* WT, int k0, int n0, int drow0, float scale, LAS float* scr, int lane) {
#pragma unroll 16
    for (int i = 0; i < 64; ++i) { const int kk = 2 * i + (lane >> 5); scr[kk * 33 + (lane & 31)] = W[(size_t)(k0 + kk) * N + n0 + (lane & 31)]; }
    LDS_WAIT(); asm volatile("" ::: "memory");
    const int c = lane & 7;
#pragma unroll
    for (int j = 0; j < 4; ++j) { const int n = (lane >> 3) + 8 * j; const LAS float* s = scr + (16 * c) * 33 + n;
        v4u o; o.x = pk4_fp8(s[0 * 33] * scale, s[1 * 33] * scale, s[2 * 33] * scale, s[3 * 33] * scale); o.y = pk4_fp8(s[4 * 33] * scale, s[5 * 33] * scale, s[6 * 33] * scale, s[7 * 33] * scale);
        o.z = pk4_fp8(s[8 * 33] * scale, s[9 * 33] * scale, s[10 * 33] * scale, s[11 * 33] * scale); o.w = pk4_fp8(s[12 * 33] * scale, s[13 * 33] * scale, s[14 * 33] * scale, s[15 * 33] * scale);
        *(v4u*)(WT + (size_t)(drow0 + n) * 1024 + k0 + 16 * c) = o; }
    LDS_WAIT(); asm volatile("" ::: "memory");
}
__device__ __forceinline__ void transpose_mat(const float* W, int K, int N, bf16* WT, int item, LAS float* scr, int lane) {
    const int nblk = N / 32, kb = item / nblk, nb = item % nblk;
    transpose_item(W, K, N, WT, 64 * kb, 32 * nb, 32 * nb, scr, lane);
}

template <class R> __device__ __forceinline__ void conv_run(const Ptrs& P, LAS unsigned char* lds, int wave, int lane, int G, R&& released);
constexpr int P0_ROW_WAVES = 2;
__device__ __forceinline__ void p0_prologue(const Ptrs& P, LAS unsigned char* lds, int wave, int lane, int G) {
    LAS float* scr = (LAS float*)(lds + wave * 17408);
    unsigned char* ws = P.ws;
    constexpr int I_IN = (D / 64) * (INW / 32), I_O = (D / 64) * (D / 32), I_UP = (POOLW / 64) * (D / 32), I_OUT = I_O, I_MIX = 4 * (128 / 64) * (128 / 32);
    constexpr int NITEMS = I_IN + I_O + I_UP + I_OUT + I_MIX;
    LAS int* rowctr = (LAS int*)(lds + MISC_OFF + 64);
    if (wave >= P0_ROW_WAVES) {
        const int gw = blockIdx.x * (NWAVES - P0_ROW_WAVES) + (wave - P0_ROW_WAVES), NGW = G * (NWAVES - P0_ROW_WAVES);
        for (int it = gw; it < NITEMS; it += NGW) {
            int r = it;
            if (r < I_IN) { const int nblk = INW / 32, kb = r / nblk, nb = r % nblk; transpose_item_qk8(P.w_in, D, INW, ws + WS_WIN, 64 * kb, 32 * nb, scr, lane); continue; } r -= I_IN;
            if (r < I_O) { transpose_mat(P.w_o, D, D, (bf16*)(ws + WS_WO), r, scr, lane); continue; } r -= I_O;
            if (r < I_UP) { transpose_mat(P.w_pool_up, POOLW, D, (bf16*)(ws + WS_WUP), r, scr, lane); continue; } r -= I_UP;
            if (r < I_OUT) { transpose_mat(P.w_out, D, D, (bf16*)(ws + WS_WOUT), r, scr, lane); continue; } r -= I_OUT;
            { const int g = r / 8, q = r % 8; transpose_mat(P.w_pool_mix + (size_t)g * 128 * 128, 128, 128, (bf16*)(ws + WS_WMIX) + (size_t)g * 128 * 128, q, scr, lane); }
        }
        for (int i = gw * 64 + lane; i < D * NE; i += NGW * 64) { const int e = i / D, k = i % D; const float w = P.w_router[(size_t)k * NE + e];
            const unsigned hi = f2bf(w); const float lo = w - __builtin_bit_cast(float, hi << 16);
            ((bf16*)(ws + WS_WRHI))[i] = (bf16)hi; ((bf16*)(ws + WS_WRLO))[i] = (bf16)f2bf(lo); }
        for (int i = gw * 64 + lane; i < NTOK * 32; i += NGW * 64) { const int tok = i >> 5, fi = i & 31;
            const float inv_freq = powf(10000.0f, -(float)(2 * fi) / 64.0f);
            const float ang = (float)P.positions[tok] * inv_freq;
            double rev = (double)ang * 0.15915494309189535; rev -= rint(rev);
            const float rf = (float)rev;
            f32x2 cs; cs.x = __builtin_amdgcn_cosf(rf); cs.y = __builtin_amdgcn_sinf(rf);
            ((f32x2*)(ws + WS_ROPE))[i] = cs; }
        { const int ngb = (NTOK / 4 - (int)blockIdx.x + G - 1) / G;
          conv_run(P, lds, wave, lane, G, [&]() { return *(volatile LAS int*)rowctr >= ngb; }); }
    }
    unsigned char* H = ws + WS_RA;
    const f32x4* gr = (const f32x4*)P.norm_mix_g + lane;
    f32x4 gg[4];
#pragma unroll
    for (int j = 0; j < 4; ++j) gg[j] = gr[64 * j];
    constexpr int NGRP = NTOK / 4;
    auto grab = [&]() { int j = 0; if (lane == 0) j = __hip_atomic_fetch_add(rowctr, 1, __ATOMIC_RELAXED, __HIP_MEMORY_SCOPE_WORKGROUP); return blockIdx.x + G * __builtin_amdgcn_readfirstlane(j); };
    int grp = grab();
    f32x4 v[4][4];
    { const int m0 = grp < NGRP ? grp * 4 : 0;
#pragma unroll
      for (int r = 0; r < 4; ++r) { const f32x4* xr = (const f32x4*)(P.x + (size_t)(m0 + r) * D) + lane;
#pragma unroll
          for (int j = 0; j < 4; ++j) v[r][j] = xr[64 * j]; } }
    while (grp < NGRP) {
        const int m0 = grp * 4;
        const int gn = grab();
        f32x4 nv[4][4];
        { const int mn = gn < NGRP ? gn * 4 : m0;
#pragma unroll
          for (int r = 0; r < 4; ++r) { const f32x4* xr = (const f32x4*)(P.x + (size_t)(mn + r) * D) + lane;
#pragma unroll
              for (int j = 0; j < 4; ++j) nv[r][j] = xr[64 * j]; } }
#pragma unroll
        for (int r = 0; r < 4; ++r) { float s = 0.f;
#pragma unroll
            for (int j = 0; j < 4; ++j) s += (v[r][j].x * v[r][j].x + v[r][j].y * v[r][j].y) + (v[r][j].z * v[r][j].z + v[r][j].w * v[r][j].w);
            const float rstd = 1.0f / sqrtf(wave_sum(s) * (1.f / D) + RMS_EPS);
            unsigned* o8 = (unsigned*)(H + (size_t)(m0 + r) * D) + lane;
#pragma unroll
            for (int j = 0; j < 4; ++j) { const f32x4 g = gg[j]; o8[64 * j] = pk4_fp8(v[r][j].x * rstd * g.x, v[r][j].y * rstd * g.y, v[r][j].z * rstd * g.z, v[r][j].w * rstd * g.w); } }
#pragma unroll
        for (int r = 0; r < 4; ++r)
#pragma unroll
            for (int j = 0; j < 4; ++j) v[r][j] = nv[r][j];
        grp = gn;
    }
}

constexpr int AT_KSTR = 72, AT_VRS = 160, AT_NK = 208;
constexpr int AT_VOFF = 30720, AT_BUF = 64000;
static_assert(AT_NK * AT_KSTR * 2 <= AT_VOFF && AT_VOFF + AT_NK * AT_VRS <= AT_BUF && 2 * AT_BUF <= RING_BYTES, "attn lds");
__device__ __forceinline__ void attn_prefetch(const bf16* Kg, const bf16* Vg, int unit, int tid, v4u (&kr)[4], v4u (&vr)[4]) {
    const int qt64 = unit % (SEQ / 64), kvh = (unit / (SEQ / 64)) % NKVH, b = unit / ((SEQ / 64) * NKVH);
    const int t0 = qt64 * 64, tokbase = b * SEQ;
#pragma unroll
    for (int i = 0; i < 4; ++i) { const int task = tid + 512 * i; const int kl = task >> 3, ds = task & 7, sk = t0 - 128 + kl;
        const bool ok = (task < AT_NK * 8) && (sk >= 0) && (kl < 192);
        const size_t off = (size_t)(tokbase + (ok ? sk : 0)) * 128 + kvh * 64 + 8 * ds;
        const v4u kk = *(const v4u*)(Kg + off), vv = *(const v4u*)(Vg + off);
        kr[i] = ok ? kk : (v4u){0u, 0u, 0u, 0u}; vr[i] = ok ? vv : (v4u){0u, 0u, 0u, 0u}; }
}
#define AT_TR8(o, addr, OFF) asm volatile( \
    "ds_read_b64_tr_b16 %0, %8 offset:%9\n\tds_read_b64_tr_b16 %1, %8 offset:%10\n\tds_read_b64_tr_b16 %2, %8 offset:%11\n\tds_read_b64_tr_b16 %3, %8 offset:%12\n\t" \
    "ds_read_b64_tr_b16 %4, %8 offset:%13\n\tds_read_b64_tr_b16 %5, %8 offset:%14\n\tds_read_b64_tr_b16 %6, %8 offset:%15\n\tds_read_b64_tr_b16 %7, %8 offset:%16\n\ts_waitcnt lgkmcnt(0)" \
    : "=&v"(o[0][0]), "=&v"(o[0][1]), "=&v"(o[1][0]), "=&v"(o[1][1]), "=&v"(o[2][0]), "=&v"(o[2][1]), "=&v"(o[3][0]), "=&v"(o[3][1]) \
    : "v"(addr), "n"((OFF)), "n"((OFF) + 2560), "n"((OFF) + 32), "n"((OFF) + 2560 + 32), "n"((OFF) + 64), "n"((OFF) + 2560 + 64), "n"((OFF) + 96), "n"((OFF) + 2560 + 96) : "memory")
__device__ __forceinline__ void attn_phase(const Ptrs& P, LAS unsigned char* lds, int tid, int wave, int lane, int G) {
    const unsigned char* ws = P.ws;
    const bf16* Qg = (const bf16*)(ws + WS_Q); const bf16* Kg = (const bf16*)(ws + WS_K); const bf16* Vg = (const bf16*)(ws + WS_V);
    bf16* Og = (bf16*)(ws + WS_RA);
    constexpr int NU = NB * NKVH * (SEQ / 64);
    int unit = blockIdx.x; if (unit >= NU) return;
    v4u kr[4], vr[4];
    attn_prefetch(Kg, Vg, unit, tid, kr, vr);
    int buf = 0;
    const int c = lane & 15, g = lane >> 4;
    const float NEG = -__builtin_inff();
    for (; unit < NU; unit += G) {
        const int qt64 = unit % (SEQ / 64), kvh = (unit / (SEQ / 64)) % NKVH, b = unit / ((SEQ / 64) * NKVH);
        const int t0 = qt64 * 64, tokbase = b * SEQ;
        LAS bf16* Kl = (LAS bf16*)(lds + buf * AT_BUF); LAS unsigned char* Vl = lds + buf * AT_BUF + AT_VOFF;
        const int hq = kvh * 8 + wave;
        const bf16* qp0 = Qg + (size_t)(tokbase + t0 + c) * 1024 + hq * 64 + 8 * g;
        bf16x8 nq0 = *(const bf16x8*)qp0, nq1 = *(const bf16x8*)(qp0 + 32);
#pragma unroll
        for (int i = 0; i < 4; ++i) { const int task = tid + 512 * i; const int kl = task >> 3, ds = task & 7;
            if (task < AT_NK * 8) { *(LAS v4u*)(Kl + kl * AT_KSTR + 8 * ds) = kr[i]; *(LAS v4u*)(Vl + kl * AT_VRS + 16 * ds) = vr[i]; } }
        if (unit + G < NU) attn_prefetch(Kg, Vg, unit + G, tid, kr, vr);
        asm volatile("s_waitcnt lgkmcnt(0)" ::: "memory"); __builtin_amdgcn_s_barrier(); asm volatile("" ::: "memory");
        const float sink = P.sinks[hq] * 1.4426950408889634f;
        const unsigned vaddr0 = (unsigned)(size_t)Vl + (unsigned)((4 * g + ((lane & 15) >> 2)) * AT_VRS + 8 * (lane & 3));
        bf16x8 nb0 = *(const bf16x8*)(qp0 + (size_t)16 * 1024), nb1 = *(const bf16x8*)(qp0 + (size_t)16 * 1024 + 32);
#pragma unroll 1
        for (int pq = 0; pq < 2; ++pq) {
            const int qa = 2 * pq;
            const int toka = tokbase + t0 + 16 * qa + c;
            const bf16x8 a0 = nq0, a1 = nq1, b0 = nb0, b1 = nb1;
            { const int qn = pq < 1 ? 2 : 3; const bf16* qp = qp0 + (size_t)(16 * qn) * 1024; nq0 = *(const bf16x8*)qp; nq1 = *(const bf16x8*)(qp + 32);
              nb0 = *(const bf16x8*)(qp + (size_t)16 * 1024 * (pq < 1 ? 1 : 0)); nb1 = *(const bf16x8*)(qp + (size_t)16 * 1024 * (pq < 1 ? 1 : 0) + 32); }
            f32x4 Sa[9], Sb[9];
#pragma unroll
            for (int u = 0; u < 10; ++u) {
                const LAS bf16* kp = Kl + (16 * (qa + u) + c) * AT_KSTR + 8 * g;
                const bf16x8 kf0 = *(const LAS bf16x8*)kp, kf1 = *(const LAS bf16x8*)(kp + 32);
                if (u < 9) { f32x4 sacc = {0.f, 0.f, 0.f, 0.f};
                    sacc = __builtin_amdgcn_mfma_f32_16x16x32_bf16(kf0, a0, sacc, 0, 0, 0); sacc = __builtin_amdgcn_mfma_f32_16x16x32_bf16(kf1, a1, sacc, 0, 0, 0); Sa[u] = sacc; }
                if (u > 0) { f32x4 sacc = {0.f, 0.f, 0.f, 0.f};
                    sacc = __builtin_amdgcn_mfma_f32_16x16x32_bf16(kf0, b0, sacc, 0, 0, 0); sacc = __builtin_amdgcn_mfma_f32_16x16x32_bf16(kf1, b1, sacc, 0, 0, 0); Sb[u - 1] = sacc; } }
#pragma unroll
            for (int r = 0; r < 4; ++r) { const bool lo = (c - 4 * g - r) < 0; Sa[0][r] = lo ? Sa[0][r] : NEG; Sa[8][r] = lo ? NEG : Sa[8][r]; Sb[0][r] = lo ? Sb[0][r] : NEG; Sb[8][r] = lo ? NEG : Sb[8][r]; }
            if (t0 < 128) {
#pragma unroll
                for (int tt = 0; tt < 9; ++tt)
#pragma unroll
                    for (int r = 0; r < 4; ++r) { const int sk = t0 - 128 + 16 * (qa + tt) + 4 * g + r; Sa[tt][r] = sk >= 0 ? Sa[tt][r] : NEG; Sb[tt][r] = (sk + 16) >= 0 ? Sb[tt][r] : NEG; } }
            float mxa = sink, mxb = sink;
#pragma unroll
            for (int tt = 0; tt < 9; ++tt) { mxa = fmaxf(fmaxf(mxa, fmaxf(Sa[tt][0], Sa[tt][1])), fmaxf(Sa[tt][2], Sa[tt][3])); mxb = fmaxf(fmaxf(mxb, fmaxf(Sb[tt][0], Sb[tt][1])), fmaxf(Sb[tt][2], Sb[tt][3])); }
            mxa = fmaxf(mxa, __shfl_xor(mxa, 16)); mxa = fmaxf(mxa, __shfl_xor(mxa, 32)); mxb = fmaxf(mxb, __shfl_xor(mxb, 16)); mxb = fmaxf(mxb, __shfl_xor(mxb, 32));
            float suma = 0.f, sumb = 0.f;
#pragma unroll
            for (int tt = 0; tt < 9; ++tt)
#pragma unroll
                for (int r = 0; r < 4; ++r) { const float pa = __builtin_amdgcn_exp2f(Sa[tt][r] - mxa); Sa[tt][r] = pa; suma += pa; const float pb = __builtin_amdgcn_exp2f(Sb[tt][r] - mxb); Sb[tt][r] = pb; sumb += pb; }
            suma += __shfl_xor(suma, 16); suma += __shfl_xor(suma, 32); sumb += __shfl_xor(sumb, 16); sumb += __shfl_xor(sumb, 32);
            suma += __builtin_amdgcn_exp2f(sink - mxa); sumb += __builtin_amdgcn_exp2f(sink - mxb);
            const float inva = 1.0f / suma, invb = 1.0f / sumb;
            f32x4 Oa[4], Ob[4];
#pragma unroll
            for (int dt = 0; dt < 4; ++dt) { Oa[dt] = (f32x4){0.f, 0.f, 0.f, 0.f}; Ob[dt] = (f32x4){0.f, 0.f, 0.f, 0.f}; }
            const unsigned vaddr = vaddr0 + (unsigned)(qa * 16 * AT_VRS);
#define AT_PK(x) pg8::cvt_pk_bf16((x)[0], (x)[1]), pg8::cvt_pk_bf16((x)[2], (x)[3])
#define AT_PV(ps) do { v2u vv[4][2]; AT_TR8(vv, vaddr, (ps) * 5120); \
                v4u pwa, pwb; { const unsigned t_[2] = {AT_PK(Sa[2 * (ps)])}; pwa.x = t_[0]; pwa.y = t_[1]; } \
                if ((ps) < 4) { const unsigned t_[2] = {AT_PK(Sa[(2 * (ps) + 1) % 9])}; pwa.z = t_[0]; pwa.w = t_[1]; } else { pwa.z = 0u; pwa.w = 0u; } \
                if ((ps) > 0) { const unsigned t_[2] = {AT_PK(Sb[(2 * (ps) + 8) % 9])}; pwb.x = t_[0]; pwb.y = t_[1]; } else { pwb.x = 0u; pwb.y = 0u; } \
                { const unsigned t_[2] = {AT_PK(Sb[2 * (ps)])}; pwb.z = t_[0]; pwb.w = t_[1]; } \
                const bf16x8 pfa = __builtin_bit_cast(bf16x8, pwa), pfb = __builtin_bit_cast(bf16x8, pwb); \
                _Pragma("unroll") for (int dt = 0; dt < 4; ++dt) { const bf16x8 vf = __builtin_bit_cast(bf16x8, (v4u){vv[dt][0].x, vv[dt][0].y, vv[dt][1].x, vv[dt][1].y}); \
                    Oa[dt] = __builtin_amdgcn_mfma_f32_16x16x32_bf16(vf, pfa, Oa[dt], 0, 0, 0); Ob[dt] = __builtin_amdgcn_mfma_f32_16x16x32_bf16(vf, pfb, Ob[dt], 0, 0, 0); } } while (0)
            AT_PV(0); AT_PV(1); AT_PV(2); AT_PV(3); AT_PV(4);
#undef AT_PV
#undef AT_PK
#pragma unroll
            for (int dp = 0; dp < 2; ++dp) {
                v2u xa, ya, xb, yb;
                xa.x = pg8::cvt_pk_bf16(Oa[2 * dp][0] * inva, Oa[2 * dp][1] * inva); xa.y = pg8::cvt_pk_bf16(Oa[2 * dp][2] * inva, Oa[2 * dp][3] * inva);
                ya.x = pg8::cvt_pk_bf16(Oa[2 * dp + 1][0] * inva, Oa[2 * dp + 1][1] * inva); ya.y = pg8::cvt_pk_bf16(Oa[2 * dp + 1][2] * inva, Oa[2 * dp + 1][3] * inva);
                xb.x = pg8::cvt_pk_bf16(Ob[2 * dp][0] * invb, Ob[2 * dp][1] * invb); xb.y = pg8::cvt_pk_bf16(Ob[2 * dp][2] * invb, Ob[2 * dp][3] * invb);
                yb.x = pg8::cvt_pk_bf16(Ob[2 * dp + 1][0] * invb, Ob[2 * dp + 1][1] * invb); yb.y = pg8::cvt_pk_bf16(Ob[2 * dp + 1][2] * invb, Ob[2 * dp + 1][3] * invb);
                const v2u a0_ = __builtin_amdgcn_permlane16_swap(xa.x, ya.x, false, false), a1_ = __builtin_amdgcn_permlane16_swap(xa.y, ya.y, false, false);
                const v2u b0_ = __builtin_amdgcn_permlane16_swap(xb.x, yb.x, false, false), b1_ = __builtin_amdgcn_permlane16_swap(xb.y, yb.y, false, false);
                const int dcol = hq * 64 + 16 * (2 * dp + (g & 1)) + 4 * (g & ~1);
                *(v4u*)(Og + (size_t)toka * 1024 + dcol) = (v4u){a0_.x, a1_.x, a0_.y, a1_.y};
                *(v4u*)(Og + (size_t)(toka + 16) * 1024 + dcol) = (v4u){b0_.x, b1_.x, b0_.y, b1_.y}; }
        }
        buf ^= 1;
    }
    asm volatile("s_waitcnt vmcnt(0) lgkmcnt(0)" ::: "memory"); __builtin_amdgcn_s_barrier(); asm volatile("" ::: "memory");
}
#undef AT_TR8

constexpr int PL_PSTR = 520;
template <int W>
__device__ __forceinline__ void pool_load(unsigned (&raw)[31], const bf16* Ug, int unit, int cp, int th) {
    const int tok0 = unit * 32, s0 = tok0 % SEQ, i0 = 16 * th;
#pragma unroll
    for (int j = 0; j < 15 + W; ++j) { const int ti = i0 - (W - 1) + j; const bool ok = s0 + ti >= 0;
        const unsigned v = *(const unsigned*)(Ug + (size_t)(tok0 + (ok ? ti : 0)) * 512 + 2 * cp); raw[j] = ok ? v : 0u; }
}
template <int W>
__device__ __forceinline__ void pool_slide(const unsigned (&raw)[31], LAS bf16* pl, int unit, int cp, int th) {
    const int tok0 = unit * 32, s0 = tok0 % SEQ, i0 = 16 * th;
    float sa = 0.f, sb = 0.f;
#pragma unroll
    for (int j = 0; j < W - 1; ++j) { sa += bflo(raw[j]); sb += bfhi(raw[j]); }
#pragma unroll
    for (int i = 0; i < 16; ++i) {
        const float ca = bflo(raw[i + W - 1]), cb = bfhi(raw[i + W - 1]);
        sa += ca; sb += cb;
        const int sp = s0 + i0 + i + 1; const float inv = sp < W ? __builtin_amdgcn_rcpf((float)sp) : (1.0f / (float)W);
        *(LAS unsigned*)(pl + (i0 + i) * PL_PSTR + 2 * cp) = pk2(sa * inv - ca, sb * inv - cb);
        sa -= bflo(raw[i]); sb -= bfhi(raw[i]);
    }
}
#define POOL_DISPATCH(fn, ...) do { if (sgrp == 0) fn<2>(__VA_ARGS__); else if (sgrp == 1) fn<4>(__VA_ARGS__); else if (sgrp == 2) fn<8>(__VA_ARGS__); else fn<16>(__VA_ARGS__); } while (0)
__device__ __forceinline__ void pool_phase(const Ptrs& P, LAS unsigned char* lds, int tid, int wave, int lane, int G) {
    const unsigned char* ws = P.ws;
    const bf16* Ug = (const bf16*)(ws + WS_U); const bf16* Wm = (const bf16*)(ws + WS_WMIX); bf16* Mx = (bf16*)(ws + WS_MIXED);
    constexpr int NU = NTOK / 32;
    int unit = blockIdx.x; if (unit >= NU) return;
    const int cp = tid & 255, th = tid >> 8, sgrp = wave & 3;
    const int grp = wave >> 1, nh = wave & 1, c = lane & 15, g = lane >> 4;
    bf16x8 wf[4][4];
#pragma unroll
    for (int s = 0; s < 4; ++s)
#pragma unroll
        for (int n = 0; n < 4; ++n) wf[s][n] = *(const bf16x8*)(Wm + ((size_t)grp * 128 + 16 * (4 * nh + n) + c) * 128 + 32 * s + 8 * g);
    f32x4 psc[4];
#pragma unroll
    for (int n = 0; n < 4; ++n) psc[n] = *(const f32x4*)(P.pool_scale + 128 * grp + 16 * (4 * nh + n) + 4 * g);
    unsigned raw[31];
    POOL_DISPATCH(pool_load, raw, Ug, unit, cp, th);
    int buf = 0;
    for (; unit < NU; unit += G) {
        LAS bf16* pl = (LAS bf16*)(lds + buf * 34816);
        POOL_DISPATCH(pool_slide, raw, pl, unit, cp, th);
        if (unit + G < NU) POOL_DISPATCH(pool_load, raw, Ug, unit + G, cp, th);
        asm volatile("s_waitcnt lgkmcnt(0)" ::: "memory"); __builtin_amdgcn_s_barrier(); asm volatile("" ::: "memory");
        const int tok0 = unit * 32;
        f32x4 acc[2][4];
#pragma unroll
        for (int mt = 0; mt < 2; ++mt)
#pragma unroll
            for (int n = 0; n < 4; ++n) acc[mt][n] = (f32x4){0.f, 0.f, 0.f, 0.f};
#pragma unroll
        for (int s = 0; s < 4; ++s) {
            bf16x8 pf[2];
#pragma unroll
            for (int mt = 0; mt < 2; ++mt) pf[mt] = *(const LAS bf16x8*)(pl + (16 * mt + c) * PL_PSTR + 128 * grp + 32 * s + 8 * g);
#pragma unroll
            for (int n = 0; n < 4; ++n)
#pragma unroll
                for (int mt = 0; mt < 2; ++mt) acc[mt][n] = __builtin_amdgcn_mfma_f32_16x16x32_bf16(wf[s][n], pf[mt], acc[mt][n], 0, 0, 0);
        }
#pragma unroll
        for (int np = 0; np < 2; ++np)
#pragma unroll
            for (int mt = 0; mt < 2; ++mt) { v2u x_, y_;
                x_.x = pk2(acc[mt][2 * np][0] * psc[2 * np].x, acc[mt][2 * np][1] * psc[2 * np].y); x_.y = pk2(acc[mt][2 * np][2] * psc[2 * np].z, acc[mt][2 * np][3] * psc[2 * np].w);
                y_.x = pk2(acc[mt][2 * np + 1][0] * psc[2 * np + 1].x, acc[mt][2 * np + 1][1] * psc[2 * np + 1].y); y_.y = pk2(acc[mt][2 * np + 1][2] * psc[2 * np + 1].z, acc[mt][2 * np + 1][3] * psc[2 * np + 1].w);
                const v2u r0 = __builtin_amdgcn_permlane16_swap(x_.x, y_.x, false, false), r1 = __builtin_amdgcn_permlane16_swap(x_.y, y_.y, false, false);
                const int d0 = 128 * grp + 16 * (4 * nh + 2 * np + (g & 1)) + 4 * (g & ~1);
                *(v4u*)(Mx + (size_t)(tok0 + 16 * mt + c) * 512 + d0) = (v4u){r0.x, r1.x, r0.y, r1.y}; }
        buf ^= 1;
    }
    asm volatile("s_waitcnt vmcnt(0) lgkmcnt(0)" ::: "memory"); __builtin_amdgcn_s_barrier(); asm volatile("" ::: "memory");
}
#undef POOL_DISPATCH

__device__ __forceinline__ void p5_rows(const Ptrs& P, LAS unsigned char* lds, int tid, int wave, int lane, int G, bool dispatch) {
    unsigned char* ws = P.ws;
    const bf16* X1 = (const bf16*)(ws + WS_X1B); unsigned char* H2 = ws + WS_H28;
    const bf16* Whi = (const bf16*)(ws + WS_WRHI); const bf16* Wlo = (const bf16*)(ws + WS_WRLO);
    int* ltok = (int*)(ws + WS_LTOK); const float* ssp = (const float*)(ws + WS_SSP); float* topw = (float*)(ws + WS_TOPW);
    unsigned* gcnt = (unsigned*)(ws + WS_CTL) + CW_GCNT;
    LAS int* tab = (LAS int*)(lds + TAB_OFF);
    LAS float* lg = (LAS float*)(lds + wave * 2048);
    const int r = lane & 15, g = lane >> 4;
    for (int g0 = blockIdx.x * NWAVES; g0 < NTOK / 16; g0 += G * NWAVES) {
        if (tid < 64) tab[T_LCNT + tid] = 0;
        for (int i = tid; i < 2 * 32 * 128; i += NWAVES * 64) { const int m = i >> 12, e = (i >> 7) & 31, ch = i & 127;
            const v4u w = *(const v4u*)((m ? Wlo : Whi) + (size_t)e * D + 8 * ch);
            *(LAS v4u*)(lds + m * 65536 + e * 2048 + ((ch ^ (e & 15)) << 4)) = w; }
        __syncthreads();
        const int row = (g0 + wave) * 16 + r;
        const bf16* xp = X1 + (size_t)row * D + 8 * g;
        f32x4 acc0 = {0.f, 0.f, 0.f, 0.f}, acc1 = {0.f, 0.f, 0.f, 0.f};
        float rstd;
        { const f32x4* sp = (const f32x4*)(ssp + (size_t)row * 16); const f32x4 s0 = sp[0], s1 = sp[1], s2 = sp[2], s3 = sp[3];
          const float ss = (((s0.x + s0.y) + (s0.z + s0.w)) + ((s1.x + s1.y) + (s1.z + s1.w))) + (((s2.x + s2.y) + (s2.z + s2.w)) + ((s3.x + s3.y) + (s3.z + s3.w)));
          rstd = 1.0f / sqrtf(ss * (1.f / D) + RMS_EPS); }
        const LAS unsigned char* wb0 = lds + r * 2048, * wb1 = lds + (16 + r) * 2048;
        v2u hprev = {0u, 0u};
#pragma unroll 4
        for (int s = 0; s < 32; ++s) {
            const v4u xw = *(const v4u*)(xp + 32 * s);
            const f32x4 v0 = (f32x4){bflo(xw.x), bfhi(xw.x), bflo(xw.y), bfhi(xw.y)} * rstd, v1 = (f32x4){bflo(xw.z), bfhi(xw.z), bflo(xw.w), bfhi(xw.w)} * rstd;
            const f32x4 ga = *(const f32x4*)(P.norm_ffn_g + 32 * s + 8 * g), gb = *(const f32x4*)(P.norm_ffn_g + 32 * s + 8 * g + 4);
            const float p[8] = {v0.x * ga.x, v0.y * ga.y, v0.z * ga.z, v0.w * ga.w, v1.x * gb.x, v1.y * gb.y, v1.z * gb.z, v1.w * gb.w};
            unsigned hi[4], lo[4];
#pragma unroll
            for (int j = 0; j < 4; ++j) { const unsigned ha = f2bf(p[2 * j]), hb = f2bf(p[2 * j + 1]); hi[j] = ha | (hb << 16);
                lo[j] = pk2(p[2 * j] - __builtin_bit_cast(float, ha << 16), p[2 * j + 1] - __builtin_bit_cast(float, hb << 16)); }
            const v4u hv = {hi[0], hi[1], hi[2], hi[3]};
            { v2u h8; h8.x = pk4_fp8(p[0], p[1], p[2], p[3]); h8.y = pk4_fp8(p[4], p[5], p[6], p[7]);
              if (s & 1) { const v2u r0 = __builtin_amdgcn_permlane16_swap(hprev.x, h8.x, false, false), r1 = __builtin_amdgcn_permlane16_swap(hprev.y, h8.y, false, false);
                  *(v4u*)(H2 + (size_t)row * D + 32 * (s - 1 + (g & 1)) + 8 * (g & ~1)) = (v4u){r0.x, r1.x, r0.y, r1.y}; }
              else hprev = h8; }
            const bf16x8 ah = __builtin_bit_cast(bf16x8, hv), al = __builtin_bit_cast(bf16x8, (v4u){lo[0], lo[1], lo[2], lo[3]});
            const int co = (((4 * s + g) ^ r) << 4);
            const bf16x8 wh0 = *(const LAS bf16x8*)(wb0 + co), wh1 = *(const LAS bf16x8*)(wb1 + co);
            const bf16x8 wl0 = *(const LAS bf16x8*)(wb0 + 65536 + co), wl1 = *(const LAS bf16x8*)(wb1 + 65536 + co);
            acc0 = __builtin_amdgcn_mfma_f32_16x16x32_bf16(wh0, ah, acc0, 0, 0, 0); acc0 = __builtin_amdgcn_mfma_f32_16x16x32_bf16(wh0, al, acc0, 0, 0, 0); acc0 = __builtin_amdgcn_mfma_f32_16x16x32_bf16(wl0, ah, acc0, 0, 0, 0);
            acc1 = __builtin_amdgcn_mfma_f32_16x16x32_bf16(wh1, ah, acc1, 0, 0, 0); acc1 = __builtin_amdgcn_mfma_f32_16x16x32_bf16(wh1, al, acc1, 0, 0, 0); acc1 = __builtin_amdgcn_mfma_f32_16x16x32_bf16(wl1, ah, acc1, 0, 0, 0);
        }
        __syncthreads();
        { const f32x4 b0 = *(const f32x4*)(P.b_router + 4 * g), b1 = *(const f32x4*)(P.b_router + 16 + 4 * g);
          *(LAS f32x4*)(lg + r * 32 + 4 * g) = acc0 + b0; *(LAS f32x4*)(lg + r * 32 + 16 + 4 * g) = acc1 + b1; }
        LDS_WAIT(); asm volatile("" ::: "memory");
        int idx[4] = {0, 0, 0, 0}; float wgt[4] = {0.f, 0.f, 0.f, 0.f}; int rank[4] = {0, 0, 0, 0};
        const int half = row >= HALF_TOK ? 1 : 0;
        if (lane < 16 && dispatch) {
            float v[32];
#pragma unroll
            for (int q = 0; q < 8; ++q) { const f32x4 t = *(const LAS f32x4*)(lg + lane * 32 + 4 * q); v[4 * q] = t.x; v[4 * q + 1] = t.y; v[4 * q + 2] = t.z; v[4 * q + 3] = t.w; }
            float val[4];
#pragma unroll
            for (int k = 0; k < 4; ++k) { float best = v[0]; int bi = 0;
#pragma unroll
                for (int e = 1; e < 32; ++e) { const bool gt = v[e] > best; best = gt ? v[e] : best; bi = gt ? e : bi; }
                val[k] = best; idx[k] = bi;
#pragma unroll
                for (int e = 0; e < 32; ++e) v[e] = (e == bi) ? -__builtin_inff() : v[e]; }
            float den = 0.f;
#pragma unroll
            for (int k = 0; k < 4; ++k) { wgt[k] = __builtin_amdgcn_exp2f((val[k] - val[0]) * 1.4426950408889634f); den += wgt[k]; }
            const float id = 1.0f / den;
#pragma unroll
            for (int k = 0; k < 4; ++k) { wgt[k] *= id; rank[k] = __hip_atomic_fetch_add(tab + T_LCNT + half * 32 + idx[k], 1, __ATOMIC_RELAXED, __HIP_MEMORY_SCOPE_WORKGROUP); }
        }
        __syncthreads();
        if (tid < 64 && dispatch) { const int cn = tab[T_LCNT + tid]; int base = 0; if (cn > 0) base = (int)__hip_atomic_fetch_add(gcnt + tid * 16, (unsigned)cn, __ATOMIC_RELAXED, __HIP_MEMORY_SCOPE_AGENT); tab[T_LBASE + tid] = base; }
        __syncthreads();
        if (lane < 16 && dispatch) {
#pragma unroll
            for (int k = 0; k < 4; ++k) { const int pos = tab[T_LBASE + half * 32 + idx[k]] + rank[k];
                if (pos < LCAP) ltok[(size_t)(half * NE + idx[k]) * LCAP + pos] = row * 4 + k;
                topw[(size_t)row * 4 + k] = wgt[k]; }
        }
        __syncthreads();
    }
}

__device__ __forceinline__ void build_tables(const Ptrs& P, LAS unsigned char* lds, int tid, int mode) {
    const unsigned* gcnt = (const unsigned*)(P.ws + WS_CTL) + CW_GCNT;
    LAS int* tab = (LAS int*)(lds + TAB_OFF); LAS unsigned* rbmap = (LAS unsigned*)(lds + RBMAP_OFF);
    __syncthreads();
    if (tid < 64) { int v = (int)__hip_atomic_load(gcnt + tid * 16, __ATOMIC_RELAXED, __HIP_MEMORY_SCOPE_AGENT); v = v < LCAP ? v : LCAP; tab[(tid < 32 ? T_CNT0 : T_CNT1 - 32) + tid] = v; }
    __syncthreads();
    if (tid < 32) {
        int ps = 0, rs = 0;
        for (int e = 0; e < tid; ++e) { const int c0 = tab[T_CNT0 + e], c1 = tab[T_CNT1 + e]; ps += (c0 + c1 + 255) >> 8;
            rs += mode == 0 ? (c0 + c1 + 255) >> 8 : (mode == 1 ? (c0 + 255) >> 8 : (c1 + 255) >> 8); }
        const int c0 = tab[T_CNT0 + tid], c1 = tab[T_CNT1 + tid];
        const int mine = mode == 0 ? (c0 + c1 + 255) >> 8 : (mode == 1 ? (c0 + 255) >> 8 : (c1 + 255) >> 8);
        tab[T_PSTART + tid] = ps * 256;
        for (int rb = 0; rb < mine; ++rb) rbmap[rs + rb] = ((unsigned)tid << 16) | (unsigned)rb;
        if (tid == 31) tab[T_NRBTOT] = rs + mine;
    }
    __syncthreads();
}

constexpr int NCONV_GU = NE * 2 * 256, NCONV = NCONV_GU + NE * 256;
__device__ __forceinline__ void conv_item(const Ptrs& P, int it, LAS float* scr, int lane) {
    const bool gu = it < NCONV_GU; const int i2 = gu ? it : it - NCONV_GU;
    const int e = gu ? i2 >> 9 : i2 >> 8, sel = (i2 >> 8) & 1, q = i2 & 255, kb = q >> 5, n0 = 32 * (q & 31);
    const float* W = (gu ? (sel ? P.w_up : P.w_gate) : P.w_down) + (size_t)e * D * DFF;
    unsigned char* WT = gu ? P.ws + WS_WGU8 + (size_t)e * 2048 * 1024 : P.ws + WS_WD8 + (size_t)e * 1024 * 1024;
    const int drow = gu ? 256 * (n0 >> 7) + 128 * sel + (n0 & 127) : n0;
    transpose_item8w(W, DFF, WT, 128 * kb, n0, drow, 64.0f, scr, lane);
}
__device__ __forceinline__ unsigned conv_grab_v(unsigned* ctr, int lane) { unsigned v = 0; if (lane == 0) v = __hip_atomic_fetch_add(ctr, 1u, __ATOMIC_RELAXED, __HIP_MEMORY_SCOPE_AGENT); return v; }
template <class R>
__device__ __forceinline__ void conv_run(const Ptrs& P, LAS unsigned char* lds, int wave, int lane, int G, R&& released) {
    LAS float* scr = (LAS float*)(lds + wave * 17408);
    unsigned* ctr0 = (unsigned*)(P.ws + WS_CTL) + CW_CONV;
    const int NGW = G * NWAVES, jmax = 8 * ((NCONV + NGW - 1) / NGW);
    const int own = blockIdx.x, partner = (own + G / 2) % G;
    for (int side = 0; side < 2; ++side) {
        const int blk = side ? partner : own; unsigned* ctr = ctr0 + 16 * blk;
        for (;;) {
            if (released()) return;
            const int j = __builtin_amdgcn_readfirstlane((int)conv_grab_v(ctr, lane));
            if (j >= jmax) break;
            const int it = (j >> 3) * NGW + blk * 8 + (j & 7);
            if (it < NCONV) conv_item(P, it, scr, lane);
        }
    }
}

__device__ __forceinline__ void p9_rows(const Ptrs& P, int wave, int lane, int G) {
    const unsigned char* Y = P.ws + WS_Y; const float* topw = (const float*)(P.ws + WS_TOPW); const bf16* X1 = (const bf16*)(P.ws + WS_X1B);
    f32x4 gf[4];
#pragma unroll
    for (int t = 0; t < 4; ++t) gf[t] = *(const f32x4*)(P.norm_final_g + 256 * t + 4 * lane);
    v2u xw[4]; unsigned yv[4][4]; f32x4 w4;
    const unsigned lo4 = 4u * (unsigned)lane, lo8 = 8u * (unsigned)lane;
#define P9_LOAD(XW, YV, W4, R0) do { const int row = (R0); \
            _Pragma("unroll") for (int t = 0; t < 4; ++t) XW[t] = *(const v2u*)((const unsigned char*)(X1 + (size_t)row * D + 256 * t) + lo8); \
            W4 = *(const f32x4*)(topw + (size_t)row * 4); \
            _Pragma("unroll") for (int k = 0; k < 4; ++k) _Pragma("unroll") for (int t = 0; t < 4; ++t) YV[k][t] = *(const unsigned*)(Y + ((size_t)row * 4 + k) * D + 256 * t + lo4); } while (0)
    { const int r00 = blockIdx.x * NWAVES + wave; P9_LOAD(xw, yv, w4, (r00 < NTOK ? r00 : 0)); }
    for (int row = blockIdx.x * NWAVES + wave; row < NTOK; row += G * NWAVES) {
        v2u nxw[4]; unsigned nyv[4][4]; f32x4 nw4;
        { const int rn = (row + G * NWAVES < NTOK) ? row + G * NWAVES : row; P9_LOAD(nxw, nyv, nw4, rn); }
        {
            f32x4 v[4];
#pragma unroll
            for (int t = 0; t < 4; ++t) { const v2u x_ = xw[t]; v[t] = (f32x4){bflo(x_.x), bfhi(x_.x), bflo(x_.y), bfhi(x_.y)}; }
            const float wk[4] = {w4.x, w4.y, w4.z, w4.w};
#pragma unroll
            for (int k = 0; k < 4; ++k) { const float wq = wk[k] * 0.125f;
#pragma unroll
                for (int t = 0; t < 4; ++t) { const f32x2 a0 = __builtin_amdgcn_cvt_pk_f32_fp8((int)yv[k][t], false), a1 = __builtin_amdgcn_cvt_pk_f32_fp8((int)yv[k][t], true);
                    v[t].x += wq * a0.x; v[t].y += wq * a0.y; v[t].z += wq * a1.x; v[t].w += wq * a1.y; } }
            float s = 0.f;
#pragma unroll
            for (int t = 0; t < 4; ++t) s += (v[t].x * v[t].x + v[t].y * v[t].y) + (v[t].z * v[t].z + v[t].w * v[t].w);
            const float rstd = 1.0f / sqrtf(wave_sum(s) * (1.f / D) + RMS_EPS);
            float* xr = P.out + (size_t)row * D;
#pragma unroll
            for (int t = 0; t < 4; ++t) *(f32x4*)((unsigned char*)(xr + 256 * t) + 4u * lo4) = v[t] * rstd * gf[t]; }
        w4 = nw4;
#pragma unroll
        for (int t = 0; t < 4; ++t) { xw[t] = nxw[t];
#pragma unroll
            for (int k = 0; k < 4; ++k) yv[k][t] = nyv[k][t]; }
    }
#undef P9_LOAD
}

struct Args { Ptrs p; int ph_lo, ph_hi; };
__global__ void __launch_bounds__(NWAVES * 64, 2) mk_fwd(Args args) {
    extern __shared__ __attribute__((aligned(16))) unsigned char lds_raw[];
    LAS unsigned char* lds = (LAS unsigned char*)lds_raw;
    const Ptrs& P = args.p;
    const int G = gridDim.x;
#define IDS() int tid = threadIdx.x; asm volatile("" : "+v"(tid)); const int lane = tid & 63, wave = __builtin_amdgcn_readfirstlane(tid >> 6); (void)lane; (void)wave
    for (int u = threadIdx.x; u < (LDS_BYTES - RING_BYTES) / 4; u += NWAVES * 64) ((LAS unsigned*)(lds + RING_BYTES))[u] = 0u;
    __syncthreads();
    unsigned* ctl = (unsigned*)(P.ws + WS_CTL);
    XcdBarrier bar; bar.bar = ctl + CW_BAR; bar.x = 0; bar.st = nullptr;
    if (N_LAUNCHES == 1) bar = xcd_barrier_post(ctl + CW_BAR, (volatile LAS unsigned*)(lds + MISC_OFF) + 8);
    const int lo = args.ph_lo, hi = args.ph_hi;
#ifndef PH_MASK
#define PH_MASK 0xFFF
#endif
#ifndef REP_MASK
#define REP_MASK 0
#endif
#define REPS(k) for (int rep_ = 0; rep_ < 1 + ((REP_MASK >> (k)) & 1); ++rep_)
#define IN(k) (((PH_MASK >> (k)) & 1) && lo <= (k) && (k) < hi)
#define SEAM(k) do { if (IN(k) && IN((k) + 1)) xcd_barrier(bar); } while (0)
#define SEAM_FILL(k) do { if (IN(k) && IN((k) + 1)) { IDS(); xcd_barrier_fill(bar, [&](auto&& rel) { conv_run(P, lds, wave, lane, G, rel); }); } } while (0)
    unsigned char* ws = P.ws;
    LAS int* tab = (LAS int*)(lds + TAB_OFF); LAS unsigned* rbmap = (LAS unsigned*)(lds + RBMAP_OFF);

    if (IN(0)) REPS(0) { IDS(); p0_prologue(P, lds, wave, lane, G); __syncthreads(); } SEAM(0);
    if (IN(1)) REPS(1) {
        PolP1 S; S.A = (const char*)(ws + WS_RA); S.B = (const char*)(ws + WS_WIN); S.bias = P.b_in; S.rope = (const f32x2*)(ws + WS_ROPE); S.Q = (bf16*)(ws + WS_Q); S.K = (bf16*)(ws + WS_K); S.V = (bf16*)(ws + WS_V);
        S.U = (bf16*)(ws + WS_U); S.G = (bf16*)(ws + WS_G); S.G_ = G; S.c = blockIdx.x;
        pg8::gemm_stream(lds, S);
    } SEAM_FILL(1);
    if (IN(2)) REPS(2) {
        IDS();
        for (int rr_ = 0; rr_ < 1 + ((REP_MASK >> 17) & 1); ++rr_) attn_phase(P, lds, tid, wave, lane, G);
        for (int rr_ = 0; rr_ < 1 + ((REP_MASK >> 18) & 1); ++rr_) pool_phase(P, lds, tid, wave, lane, G);
    } SEAM_FILL(2);
    if (IN(3)) REPS(3) {
        PolP3 S; S.A0 = (const char*)(ws + WS_RA); S.B0 = (const char*)(ws + WS_WO); S.A1 = (const char*)(ws + WS_MIXED); S.B1 = (const char*)(ws + WS_WUP); S.bo = P.b_o;
        S.G = (const bf16*)(ws + WS_G); S.O = (bf16*)(ws + WS_MERGED); S.G_ = G; S.c = blockIdx.x;
        pg8::gemm_stream(lds, S);
    } SEAM_FILL(3);
    if (IN(4)) REPS(4) {
        PolP4 S; S.A = (const char*)(ws + WS_MERGED); S.B = (const char*)(ws + WS_WOUT); S.x = P.x; S.out = (bf16*)(ws + WS_X1B); S.ssp = (float*)(ws + WS_SSP); S.G_ = G; S.c = blockIdx.x;
        pg8::gemm_stream(lds, S);
    } SEAM_FILL(4);
    if (IN(5)) { IDS(); p5_rows(P, lds, tid, wave, lane, G, true); conv_run(P, lds, wave, lane, G, []() { return false; }); __syncthreads(); } SEAM(5);
    if (IN(6)) REPS(6) {
        { IDS(); build_tables(P, lds, tid, 0); }
        PolP7 S; S.H2 = (const char*)(ws + WS_H28); S.W = (const char*)(ws + WS_WGU8); S.ltok = (const int*)(ws + WS_LTOK); S.bg = P.b_gate; S.bu = P.b_up;
        S.a = ws + WS_A8; S.tab = tab; S.rbmap = rbmap; S.G_ = G; S.c = blockIdx.x;
        pg8::gemm_stream(lds, S);
    } SEAM(6);
    if (IN(7)) REPS(7) {
        { IDS(); build_tables(P, lds, tid, 0); }
        PolP8 S; S.Aa = (const char*)(ws + WS_A8); S.W = (const char*)(ws + WS_WD8); S.ltok = (const int*)(ws + WS_LTOK); S.bd = P.b_down; S.Y = ws + WS_Y; S.tab = tab; S.rbmap = rbmap; S.G_ = G; S.c = blockIdx.x;
        pg8::gemm_stream(lds, S);
    } SEAM(7);
    if (IN(8)) { IDS(); p9_rows(P, wave, lane, G); }
#undef IN
#undef SEAM
#undef IDS
}

extern "C" void kernel_launch(void* const* d_in, const int* in_sizes, int n_in, void* d_out, int out_size, void* d_ws, size_t ws_size, hipStream_t stream) {
    static int grid = 0;
    if (grid == 0) {
        if (n_in != 22 || out_size != NTOK * D || ws_size < WS_END) { fprintf(stderr, "kernel_launch: unexpected shapes (n_in %d out %d ws %zu)\n", n_in, out_size, ws_size); grid = -1; return; }
        int dev = 0, cus = 0;
        if (hipGetDevice(&dev) != hipSuccess || hipDeviceGetAttribute(&cus, hipDeviceAttributeMultiprocessorCount, dev) != hipSuccess) { grid = -1; return; }
        if (hipFuncSetAttribute((const void*)mk_fwd, hipFuncAttributeMaxDynamicSharedMemorySize, LDS_BYTES) != hipSuccess) { grid = -1; return; }
        int per_cu = 0;
        if (hipOccupancyMaxActiveBlocksPerMultiprocessor(&per_cu, (const void*)mk_fwd, NWAVES * 64, LDS_BYTES) != hipSuccess || per_cu < 1) fprintf(stderr, "kernel_launch: occupancy query says %d\n", per_cu);
        (void)hipGetLastError();
        grid = cus > 0 ? cus : 256;
    }
    if (grid < 0) return;
    (void)hipMemsetAsync((char*)d_ws + WS_CTL, 0, CTL_ZERO_BYTES, stream);
    Args a{};
    const float** pf = (const float**)&a.p;
    a.p.x = (const float*)d_in[0]; a.p.positions = (const int*)d_in[1]; a.p.norm_mix_g = (const float*)d_in[2]; a.p.w_in = (const float*)d_in[3]; a.p.b_in = (const float*)d_in[4];
    a.p.sinks = (const float*)d_in[5]; a.p.w_o = (const float*)d_in[6]; a.p.b_o = (const float*)d_in[7]; a.p.w_pool_mix = (const float*)d_in[8]; a.p.pool_scale = (const float*)d_in[9];
    a.p.w_pool_up = (const float*)d_in[10]; a.p.w_out = (const float*)d_in[11]; a.p.norm_ffn_g = (const float*)d_in[12]; a.p.w_router = (const float*)d_in[13]; a.p.b_router = (const float*)d_in[14];
    a.p.w_gate = (const float*)d_in[15]; a.p.b_gate = (const float*)d_in[16]; a.p.w_up = (const float*)d_in[17]; a.p.b_up = (const float*)d_in[18]; a.p.w_down = (const float*)d_in[19];
    a.p.b_down = (const float*)d_in[20]; a.p.norm_final_g = (const float*)d_in[21]; a.p.out = (float*)d_out; a.p.ws = (unsigned char*)d_ws;
    (void)pf;
    if (N_LAUNCHES == 1) { a.ph_lo = 0; a.ph_hi = NPHASE; hipLaunchKernelGGL(mk_fwd, dim3(grid), dim3(NWAVES * 64), LDS_BYTES, stream, a); }
    else { for (int ph = 0; ph < NPHASE; ++ph) { a.ph_lo = ph; a.ph_hi = ph + 1; hipLaunchKernelGGL(mk_fwd, dim3(grid), dim3(NWAVES * 64), LDS_BYTES, stream, a); } }
}
```

```cpp
#include <hip/hip_runtime.h>
#include <cstdio>
#include <cstddef>

#ifndef MK_N_LAUNCHES
#define MK_N_LAUNCHES 1
#endif

#define GAS __attribute__((address_space(1)))
#define LAS __attribute__((address_space(3)))
typedef unsigned short bf16;
typedef unsigned v4u __attribute__((ext_vector_type(4)));
typedef unsigned v2u __attribute__((ext_vector_type(2)));
typedef float f32x4 __attribute__((ext_vector_type(4)));
typedef float f32x2 __attribute__((ext_vector_type(2)));
typedef short bf16x8 __attribute__((ext_vector_type(8)));
typedef int v8i __attribute__((ext_vector_type(8)));
typedef int v4i __attribute__((ext_vector_type(4)));
typedef GAS unsigned gu32;
#define RLX_AGENT __ATOMIC_RELAXED, __HIP_MEMORY_SCOPE_AGENT
#define LDS_WAIT() asm volatile("s_waitcnt lgkmcnt(0)" ::: "memory")
#define VM_WAIT() asm volatile("s_waitcnt vmcnt(0)" ::: "memory")

constexpr int NB = 8, SEQ = 4096, D = 1024, NTOK = NB * SEQ;
constexpr int HD = 64, NQH = 16, NKVH = 2;
constexpr int POOLW = 512;
constexpr int INW = 3840;
constexpr int NE = 32, DFF = 1024;
constexpr int HALF_TOK = NTOK / 2;
constexpr int LCAP = 16384;
constexpr float RMS_EPS = 1e-5f;
constexpr int NWAVES = 8;
constexpr int NPHASE = 9;
constexpr int N_LAUNCHES = MK_N_LAUNCHES;

constexpr size_t MiB = 1u << 20;
constexpr size_t WS_CTL = 0, CTL_ZERO_BYTES = 1 * MiB;
constexpr size_t WS_ROPE = 1 * MiB;
constexpr size_t WS_TOPW = 9 * MiB;
constexpr size_t WS_LTOK = 10 * MiB;
constexpr size_t WS_SSP = 14 * MiB;
constexpr size_t WS_WRHI = 18 * MiB;
constexpr size_t WS_WRLO = 18 * MiB + 65536;
constexpr size_t WS_WMIX = 18 * MiB + 2 * 65536;
constexpr size_t WS_WIN = 19 * MiB;
constexpr size_t WS_WO = 27 * MiB;
constexpr size_t WS_WUP = 29 * MiB;
constexpr size_t WS_WOUT = 30 * MiB;
constexpr size_t WS_WD8 = 32 * MiB;
constexpr size_t WS_RA = 64 * MiB;
constexpr size_t WS_RB = 128 * MiB;
constexpr size_t WS_Q = WS_RB, WS_K = WS_Q + 64 * MiB, WS_V = WS_K + 8 * MiB, WS_U = WS_V + 8 * MiB, WS_G = WS_U + 32 * MiB;
constexpr size_t WS_MIXED = 368 * MiB, WS_MERGED = 400 * MiB;
constexpr size_t WS_END = 528 * MiB;
constexpr size_t WS_A8 = 64 * MiB;
constexpr size_t WS_Y = 201 * MiB;
constexpr size_t WS_X1B = 329 * MiB;
constexpr size_t WS_H28 = 208 * MiB;
constexpr size_t WS_WGU8 = 464 * MiB;
static_assert(WS_Y + 128 * MiB <= WS_X1B && WS_A8 + 137 * MiB <= WS_Y && WS_X1B + 64 * MiB <= WS_MERGED && WS_MERGED + 64 * MiB <= WS_WGU8 && WS_WGU8 + 64 * MiB <= WS_END, "ws map");
static_assert(WS_G + 128 * MiB <= WS_MIXED, "ws map");
constexpr int CW_TMO = 0;
constexpr int CW_BAR = 4096;
constexpr int CW_GCNT = 8192;
constexpr int CW_CONV = 12288;

constexpr int RING_BYTES = 131072;
constexpr int TAB_OFF = RING_BYTES;
constexpr int T_CNT0 = 0, T_CNT1 = 32, T_PSTART = 64, T_NRBTOT = 100, T_LCNT = 128, T_LBASE = 192;
constexpr int RBMAP_OFF = RING_BYTES + 1024;
constexpr int MISC_OFF = RING_BYTES + 8192;
constexpr int LDS_BYTES = 147456;

__device__ __forceinline__ unsigned f2bf(float f) { unsigned u = __builtin_bit_cast(unsigned, f); return (u + 0x7fffu + ((u >> 16) & 1u)) >> 16; }
__device__ __forceinline__ unsigned pk2(float lo, float hi) { unsigned r; asm("v_cvt_pk_bf16_f32 %0, %1, %2" : "=v"(r) : "v"(lo), "v"(hi)); return r; }
__device__ __forceinline__ float bflo(unsigned w) { return __builtin_bit_cast(float, w << 16); }
__device__ __forceinline__ float bfhi(unsigned w) { return __builtin_bit_cast(float, w & 0xffff0000u); }
__device__ __forceinline__ float sigmoidf_(float x) { return __builtin_amdgcn_rcpf(1.0f + __builtin_amdgcn_exp2f(-1.4426950408889634f * x)); }

#define XB_TMO      128
#define XB_XCNT(j)  (256  + 64 * (j))
#define XB_XSUB(j)  (1280 + 64 * (j))
#define XB_XGEN(j)  (2304 + 64 * (j))
#define XB_TOP      3328
#define XB_TOPGEN   3392
#define XCD_BAR_WORDS 3456
#define XB_SPIN_CAP (1u << 18)
__device__ __forceinline__ unsigned xb_ld(unsigned* p)              { return __hip_atomic_load(p, __ATOMIC_RELAXED, __HIP_MEMORY_SCOPE_AGENT); }
__device__ __forceinline__ unsigned xb_add(unsigned* p, unsigned v) { return __hip_atomic_fetch_add(p, v, __ATOMIC_RELAXED, __HIP_MEMORY_SCOPE_AGENT); }
__device__ __forceinline__ unsigned xb_xcc_id() { return (unsigned)__builtin_amdgcn_s_getreg((3 << 11) | 20) & 0xFu; }
#define XB_SPIN(cond, bar) do { unsigned _sp = 0; while (cond) { __builtin_amdgcn_s_sleep(1); \
    if ((++_sp & 255u) == 0u) { if (xb_ld(&(bar)[XB_TMO])) break; if (_sp > XB_SPIN_CAP) { atomicAdd(&(bar)[XB_TMO], 1u); break; } } } } while (0)
struct XcdBarrier { unsigned* bar; unsigned x; volatile LAS unsigned* st; };
__device__ __forceinline__ XcdBarrier xcd_barrier_post(unsigned* bar, volatile LAS unsigned* st) {
    XcdBarrier b; b.bar = bar; b.x = xb_xcc_id(); b.st = st;
    if (threadIdx.x == 0) (void)xb_add(&bar[XB_XCNT(b.x)], 1u);
    return b;
}
__device__ __forceinline__ void xcd_barrier_complete(unsigned* bar, unsigned x, unsigned& nloc, unsigned& nx) {
    const unsigned G = gridDim.x * gridDim.y * gridDim.z;
    unsigned sum, cnt, mine, sp = 0u;
    for (;;) {
        sum = 0u; cnt = 0u; mine = 0u;
#pragma unroll
        for (unsigned j = 0; j < 16; ++j) { const unsigned c = xb_ld(&bar[XB_XCNT(j)]); sum += c; cnt += (c > 0u) ? 1u : 0u; mine = (j == x) ? c : mine; }
        if (sum == G) break;
        __builtin_amdgcn_s_sleep(1);
        if ((++sp & 255u) == 0u) { if (xb_ld(&bar[XB_TMO])) break; if (sp > XB_SPIN_CAP) { atomicAdd(&bar[XB_TMO], 1u); break; } }
    }
    nloc = mine > 0u ? mine : 1u; nx = cnt > 0u ? cnt : 1u;
}
__device__ __forceinline__ void xcd_barrier(const XcdBarrier& b) {
    asm volatile("s_waitcnt vmcnt(0)" ::: "memory");
    __syncthreads();
    if (threadIdx.x == 0) {
        unsigned* bar = b.bar;
        __builtin_amdgcn_s_waitcnt(0);
        unsigned nloc = b.st[0], nx = b.st[1];
        if (nloc == 0u) { xcd_barrier_complete(bar, b.x, nloc, nx); b.st[0] = nloc; b.st[1] = nx; }
        const unsigned old = xb_add(&bar[XB_XSUB(b.x)], 1u);
        const unsigned gen = old / nloc;
        if (old + 1u == (gen + 1u) * nloc) {
            __builtin_amdgcn_fence(__ATOMIC_RELEASE, "agent");
            asm volatile("s_waitcnt vmcnt(0)" ::: "memory");
            const unsigned og = xb_add(&bar[XB_TOP], 1u);
            const unsigned tg = og / nx;
            if (og + 1u == (tg + 1u) * nx) xb_add(&bar[XB_TOPGEN], 1u);
            else XB_SPIN(xb_ld(&bar[XB_TOPGEN]) == tg, bar);
            __builtin_amdgcn_fence(__ATOMIC_ACQUIRE, "agent");
            xb_add(&bar[XB_XGEN(b.x)], 1u);
            asm volatile("s_waitcnt vmcnt(0)" ::: "memory");
        } else {
            XB_SPIN(xb_ld(&bar[XB_XGEN(b.x)]) == gen, bar);
            __builtin_amdgcn_fence(__ATOMIC_ACQUIRE, "agent");
            asm volatile("s_waitcnt vmcnt(0)" ::: "memory");
        }
    }
    __syncthreads();
}

template <class F>
__device__ __forceinline__ void xcd_barrier_fill(const XcdBarrier& b, F&& fill) {
    asm volatile("s_waitcnt vmcnt(0)" ::: "memory");
    __syncthreads();
    if (threadIdx.x == 0) {
        unsigned* bar = b.bar;
        __builtin_amdgcn_s_waitcnt(0);
        unsigned nloc = b.st[0], nx = b.st[1];
        if (nloc == 0u) { xcd_barrier_complete(bar, b.x, nloc, nx); b.st[0] = nloc; b.st[1] = nx; }
        const unsigned old = xb_add(&bar[XB_XSUB(b.x)], 1u);
        const unsigned gen = old / nloc;
        b.st[2] = gen; b.st[3] = (old + 1u == (gen + 1u) * nloc) ? 1u : 0u;
    }
    __syncthreads();
    const unsigned gen = b.st[2], leader = b.st[3];
    if (!leader) { unsigned* xg = &b.bar[XB_XGEN(b.x)]; fill([&]() { return xb_ld(xg) != gen; }); }
    asm volatile("s_waitcnt vmcnt(0)" ::: "memory");
    __syncthreads();
    if (threadIdx.x == 0) {
        unsigned* bar = b.bar;
        if (leader) {
            const unsigned nx = b.st[1];
            __builtin_amdgcn_fence(__ATOMIC_RELEASE, "agent");
            asm volatile("s_waitcnt vmcnt(0)" ::: "memory");
            const unsigned og = xb_add(&bar[XB_TOP], 1u);
            const unsigned tg = og / nx;
            if (og + 1u == (tg + 1u) * nx) xb_add(&bar[XB_TOPGEN], 1u);
            else XB_SPIN(xb_ld(&bar[XB_TOPGEN]) == tg, bar);
            __builtin_amdgcn_fence(__ATOMIC_ACQUIRE, "agent");
            xb_add(&bar[XB_XGEN(b.x)], 1u);
            asm volatile("s_waitcnt vmcnt(0)" ::: "memory");
        } else {
            XB_SPIN(xb_ld(&bar[XB_XGEN(b.x)]) == gen, bar);
            __builtin_amdgcn_fence(__ATOMIC_ACQUIRE, "agent");
            asm volatile("s_waitcnt vmcnt(0)" ::: "memory");
        }
    }
    __syncthreads();
}

namespace pg8 {
constexpr int BM = 256, BK = 64, HALF = 128, HTB = HALF * BK * 2, NXCD = 8, WGM = 8;
__device__ __forceinline__ int lds_byte(int r, int c) { const int st = (r >> 4) * 2 + (c >> 5), rr = r & 15, cc = c & 31, ob = rr * 64 + cc * 2; return st * 1024 + (ob ^ (((ob >> 9) & 1) << 5)); }
__device__ __forceinline__ void stage_rc(int b, int& R, int& C) { const int st = b / 1024, sb = b % 1024, swz = sb ^ (((sb >> 9) & 1) << 5); R = (st >> 1) * 16 + swz / 64; C = (st & 1) * 32 + (swz % 64) / 2; }
__device__ __forceinline__ int perm32(int rho) { const int n = rho >> 4, i = rho & 15; return 8 * (i >> 2) + 4 * n + (i & 3); }

struct Unit { const char* A; const char* B; int nt; int ldb; int kind; int pm; int pn; int e; int r0; int aux; };
__device__ __forceinline__ bool tile_order(int nM, int nN, int G, int c, int i, int& pm, int& pn) {
    const int nwg = nM * nN; const long L = (long)i * G + c; if (L >= nwg) return false;
    int wgid = (int)L; { const int q = nwg / NXCD, r = nwg % NXCD, xcd = wgid % NXCD, off = wgid / NXCD; wgid = (xcd < r ? xcd * (q + 1) : r * (q + 1) + (xcd - r) * q) + off; }
    const int nig = WGM * nN, gid = wgid / nig, fm = gid * WGM, gsz = (nM - fm) < WGM ? (nM - fm) : WGM;
    pm = fm + ((wgid % nig) % gsz); pn = (wgid % nig) / gsz; return true;
}
__device__ __forceinline__ unsigned cvt_pk_bf16(float lo, float hi) { unsigned r; asm volatile("v_cvt_pk_bf16_f32 %0, %1, %2" : "=v"(r) : "v"(lo), "v"(hi)); return r; }

template <class P>
__device__ __forceinline__ void gemm_stream(LAS unsigned char* lds, const P& S) {
    int tid = threadIdx.x; asm volatile("" : "+v"(tid));
    const int wid = __builtin_amdgcn_readfirstlane(tid >> 6), lane = tid & 63, wr = wid >> 2, wc = wid & 3, fr = lane & 15, fq = lane >> 4;
    int Rb[2], C2[2];
#pragma unroll
    for (int i = 0; i < 2; ++i) { int R, C; stage_rc(tid * 16 + i * 8192, R, C); Rb[i] = P::PERM ? ((R & ~31) + perm32(R & 31)) : R; C2[i] = C * 2; }
    const size_t kstep = (size_t)(BK * 2);
    const unsigned ldsw = (unsigned)wid * 1024u;
    const int aoff = lds_byte(wr * 64 + fr, fq * 8), boff = lds_byte(wc * 32 + fr, fq * 8);
#define PG8_SA(b, h) (((b) * 2 + (h)) * HTB)
#define PG8_SB(b, h) ((4 + (b) * 2 + (h)) * HTB)
#define PG8_STAGE2(bufoff, gbase, v0, v1) do { \
        __builtin_amdgcn_global_load_lds((const unsigned*)((const char*)(gbase) + (v0)), (LAS unsigned*)(lds + (bufoff) + ldsw), 16, 0, 0); \
        __builtin_amdgcn_global_load_lds((const unsigned*)((const char*)(gbase) + (v1)), (LAS unsigned*)(lds + (bufoff) + ldsw + 8192), 16, 0, 0); } while (0)
#define PG8_LDA(dst, b, h) do { _Pragma("unroll") for (int m = 0; m < 4; ++m) { const v4i lo_ = *(const LAS v4i*)(lds + PG8_SA(b, h) + aoff + m * 2048), hi_ = *(const LAS v4i*)(lds + PG8_SA(b, h) + aoff + m * 2048 + 1024); dst[m] = __builtin_shufflevector(lo_, hi_, 0, 1, 2, 3, 4, 5, 6, 7); } } while (0)
#define PG8_LDB(dst, b, h) do { _Pragma("unroll") for (int n = 0; n < 2; ++n) { const v4i lo_ = *(const LAS v4i*)(lds + PG8_SB(b, h) + boff + n * 2048), hi_ = *(const LAS v4i*)(lds + PG8_SB(b, h) + boff + n * 2048 + 1024); dst[n] = __builtin_shufflevector(lo_, hi_, 0, 1, 2, 3, 4, 5, 6, 7); } } while (0)
#define PG8_LO(x) __builtin_bit_cast(bf16x8, __builtin_shufflevector((x), (x), 0, 1, 2, 3))
#define PG8_HI(x) __builtin_bit_cast(bf16x8, __builtin_shufflevector((x), (x), 4, 5, 6, 7))
#define PG8_MMA(ai, bj, At, Bt) do { __builtin_amdgcn_s_setprio(1); \
        if constexpr (P::FP8) { _Pragma("unroll") for (int m = 0; m < 4; ++m) _Pragma("unroll") for (int n = 0; n < 2; ++n) \
            asm volatile("v_mfma_f32_16x16x128_f8f6f4 %0, %1, %2, %0" : "+v"(acc[ai][bj][m][n]) : "v"(Bt[n]), "v"(At[m])); } \
        else { _Pragma("unroll") for (int m = 0; m < 4; ++m) _Pragma("unroll") for (int n = 0; n < 2; ++n) { \
            acc[ai][bj][m][n] = __builtin_amdgcn_mfma_f32_16x16x32_bf16(PG8_LO(Bt[n]), PG8_LO(At[m]), acc[ai][bj][m][n], 0, 0, 0); \
            acc[ai][bj][m][n] = __builtin_amdgcn_mfma_f32_16x16x32_bf16(PG8_HI(Bt[n]), PG8_HI(At[m]), acc[ai][bj][m][n], 0, 0, 0); } } \
        __builtin_amdgcn_s_setprio(0); } while (0)
#define PG8_WAIT_V(n) asm volatile("s_waitcnt vmcnt(" #n ")" ::: "memory")
#define PG8_WAIT_L(n) asm volatile("s_waitcnt lgkmcnt(" #n ")" ::: "memory")
#define PG8_BAR __builtin_amdgcn_s_barrier()
#define PG8_SCHED __builtin_amdgcn_sched_barrier(0)
    Unit cur, nxt; int ui = 0;
    if (!S.next(0, cur)) return;
    f32x4 acc[2][2][4][2];
#pragma unroll
    for (int a = 0; a < 2; ++a)
#pragma unroll
        for (int b = 0; b < 2; ++b)
#pragma unroll
            for (int m = 0; m < 4; ++m)
#pragma unroll
                for (int n = 0; n < 2; ++n) acc[a][b][m][n] = (f32x4){0.f, 0.f, 0.f, 0.f};
    v8i At[4], B0[2], B1[2];
    unsigned vA[2][2], vB[2];
    { int idx0[2][2] = {{0, 0}, {0, 0}}; S.lane_issue(cur, tid, idx0); S.lane_finish(cur, tid, idx0, vA); }
    vB[0] = (unsigned)(Rb[0] * cur.ldb + C2[0]); vB[1] = (unsigned)(Rb[1] * cur.ldb + C2[1]);
    const char* cA = cur.A; const char* cB = cur.B; size_t hB = (size_t)HALF * cur.ldb;
    PG8_STAGE2(PG8_SB(0, 0), cB, vB[0], vB[1]); PG8_STAGE2(PG8_SB(0, 1), cB + hB, vB[0], vB[1]); PG8_STAGE2(PG8_SA(0, 0), cA, vA[0][0], vA[0][1]); PG8_STAGE2(PG8_SA(0, 1), cA, vA[1][0], vA[1][1]);
    if (wr == 1) PG8_BAR;
    PG8_WAIT_V(2); PG8_BAR;
    PG8_STAGE2(PG8_SB(1, 0), cB + kstep, vB[0], vB[1]); PG8_STAGE2(PG8_SA(1, 0), cA + kstep, vA[0][0], vA[0][1]); PG8_STAGE2(PG8_SB(1, 1), cB + hB + kstep, vB[0], vB[1]);
    PG8_WAIT_V(6); PG8_BAR;
    for (;;) {
        bool has_next = false;
        const int nt = cur.nt;
        unsigned nvA[2][2], nvB[2];
        const char* nA = cA; const char* nB = cB; size_t nhB = hB;
#pragma unroll
        for (int h = 0; h < 2; ++h) { nvA[h][0] = vA[h][0]; nvA[h][1] = vA[h][1]; }
        nvB[0] = vB[0]; nvB[1] = vB[1];
        int nidx[2][2] = {{0, 0}, {0, 0}};
#pragma unroll 1
        for (int t = 0; t < nt; t += 2) {
            const bool last = (t == nt - 2);
            if (t == 0) { has_next = S.next(ui + 1, nxt); if (has_next) { if constexpr (!P::UNIFORM_A) S.lane_issue_asm(nxt, tid, nidx); } }
            if (last && has_next) { nA = nxt.A; nB = nxt.B; }
            const char* a1 = cA + (size_t)(t + 1) * kstep;
            const char* a2 = last ? nA : cA + (size_t)(t + 2) * kstep; const char* b2 = last ? nB : cB + (size_t)(t + 2) * kstep;
            const char* a3 = a2 + kstep; const char* b3 = b2 + kstep;
            const size_t h2 = (!P::UNIFORM_B && last) ? nhB : hB;
            const unsigned xa00 = (!P::UNIFORM_A && last) ? nvA[0][0] : vA[0][0], xa01 = (!P::UNIFORM_A && last) ? nvA[0][1] : vA[0][1], xa10 = (!P::UNIFORM_A && last) ? nvA[1][0] : vA[1][0], xa11 = (!P::UNIFORM_A && last) ? nvA[1][1] : vA[1][1];
            const unsigned xb0 = (!P::UNIFORM_B && last) ? nvB[0] : vB[0], xb1 = (!P::UNIFORM_B && last) ? nvB[1] : vB[1];
            PG8_LDB(B0, 0, 0); PG8_LDB(B1, 0, 1); PG8_SCHED; PG8_LDA(At, 0, 0); PG8_STAGE2(PG8_SA(1, 1), a1, vA[1][0], vA[1][1]);
            PG8_WAIT_V(8); PG8_WAIT_L(0); PG8_BAR; PG8_MMA(0, 0, At, B0); PG8_MMA(0, 1, At, B1); PG8_BAR; PG8_SCHED;
            PG8_LDA(At, 0, 1); PG8_STAGE2(PG8_SB(0, 0), b2, xb0, xb1); PG8_STAGE2(PG8_SB(0, 1), b2 + h2, xb0, xb1); PG8_STAGE2(PG8_SA(0, 0), a2, xa00, xa01);
            PG8_WAIT_V(8); PG8_WAIT_L(0); PG8_BAR; PG8_MMA(1, 0, At, B0); PG8_MMA(1, 1, At, B1); PG8_BAR; PG8_SCHED;
            PG8_LDB(B0, 1, 0); PG8_LDB(B1, 1, 1); PG8_SCHED; PG8_LDA(At, 1, 0); PG8_STAGE2(PG8_SA(0, 1), a2, xa10, xa11);
            PG8_WAIT_V(8); PG8_WAIT_L(0); PG8_BAR; PG8_MMA(0, 0, At, B0); PG8_MMA(0, 1, At, B1); PG8_BAR; PG8_SCHED;
            PG8_LDA(At, 1, 1); PG8_STAGE2(PG8_SB(1, 0), b3, xb0, xb1); PG8_STAGE2(PG8_SB(1, 1), b3 + h2, xb0, xb1); PG8_STAGE2(PG8_SA(1, 0), a3, xa00, xa01);
            PG8_WAIT_V(8); PG8_WAIT_L(0); PG8_BAR; PG8_MMA(1, 0, At, B0); PG8_MMA(1, 1, At, B1); PG8_BAR; PG8_SCHED;
            if (t == 0 && has_next) {
                if constexpr (!P::UNIFORM_A) { asm volatile("" : "+v"(nidx[0][0]), "+v"(nidx[0][1]), "+v"(nidx[1][0]), "+v"(nidx[1][1])); S.lane_finish(nxt, tid, nidx, nvA); }
                if constexpr (!P::UNIFORM_B) { nvB[0] = (unsigned)(Rb[0] * nxt.ldb + C2[0]); nvB[1] = (unsigned)(Rb[1] * nxt.ldb + C2[1]); nhB = (size_t)HALF * nxt.ldb; }
            }
        }
        if (wr == 0) PG8_BAR;
        if constexpr (P::FP8) asm volatile("s_nop 15\n\ts_nop 15" ::: "memory");
        S.epilogue(acc, cur, wr, wc, fr, fq);
        if (!has_next) break;
        if (!S.keep_acc(cur)) {
#pragma unroll
            for (int a = 0; a < 2; ++a)
#pragma unroll
                for (int b = 0; b < 2; ++b)
#pragma unroll
                    for (int m = 0; m < 4; ++m)
#pragma unroll
                        for (int n = 0; n < 2; ++n) acc[a][b][m][n] = (f32x4){0.f, 0.f, 0.f, 0.f};
        }
        cur = nxt; cA = nA; cB = nB; ++ui;
        if constexpr (!P::UNIFORM_A) {
#pragma unroll
            for (int h = 0; h < 2; ++h) { vA[h][0] = nvA[h][0]; vA[h][1] = nvA[h][1]; } }
        if constexpr (!P::UNIFORM_B) { vB[0] = nvB[0]; vB[1] = nvB[1]; hB = nhB; }
        if (wr == 1) PG8_BAR;
    }
    PG8_WAIT_V(0);
    PG8_BAR;
#undef PG8_SA
#undef PG8_SB
#undef PG8_STAGE2
#undef PG8_LDA
#undef PG8_LDB
#undef PG8_MMA
#undef PG8_LO
#undef PG8_HI
#undef PG8_WAIT_V
#undef PG8_WAIT_L
#undef PG8_BAR
#undef PG8_SCHED
}
}

struct Ptrs {
    const float* x; const int* positions; const float* norm_mix_g; const float* w_in; const float* b_in; const float* sinks; const float* w_o; const float* b_o;
    const float* w_pool_mix; const float* pool_scale; const float* w_pool_up; const float* w_out; const float* norm_ffn_g; const float* w_router; const float* b_router;
    const float* w_gate; const float* b_gate; const float* w_up; const float* b_up; const float* w_down; const float* b_down; const float* norm_final_g;
    float* out; unsigned char* ws;
};

struct PolP1 {
    static constexpr bool FP8 = true, UNIFORM_A = true, UNIFORM_B = true;
    static constexpr float SC = 1.0f / 64.0f;
    static constexpr bool PERM = true;
    const char* A; const char* B; const float* bias; const f32x2* rope; bf16 *Q, *K, *V, *U, *G; int G_, c;
    __device__ __forceinline__ bool next(int i, pg8::Unit& u) const {
        int pm, pn; if (!pg8::tile_order(NTOK / 256, INW / 256, G_, c, i, pm, pn)) return false;
        u.pm = pm; u.pn = pn; u.A = A + (size_t)pm * 256 * 1024; u.B = B + (size_t)pn * 256 * 1024; u.nt = 8; u.ldb = 1024; u.kind = 0; u.e = 0; u.r0 = 0; u.aux = 0; return true; }
    __device__ __forceinline__ void lane_issue(const pg8::Unit&, int, int (&)[2][2]) const {}
    __device__ __forceinline__ void lane_issue_asm(const pg8::Unit&, int, int (&)[2][2]) const {}
    __device__ __forceinline__ void lane_finish(const pg8::Unit&, int tid_, const int (&)[2][2], unsigned (&va)[2][2]) const {
        int R[2], C2[2];
#pragma unroll
        for (int i_ = 0; i_ < 2; ++i_) { int C_; pg8::stage_rc(tid_ * 16 + i_ * 8192, R[i_], C_); C2[i_] = C_ * 2; }
#pragma unroll
        for (int h = 0; h < 2; ++h) { va[h][0] = (unsigned)((R[0] + 128 * h) * 1024 + C2[0]); va[h][1] = (unsigned)((R[1] + 128 * h) * 1024 + C2[1]); } }
    __device__ __forceinline__ bool keep_acc(const pg8::Unit&) const { return false; }
    __device__ __forceinline__ void epilogue(f32x4 (&acc)[2][2][4][2], const pg8::Unit& u, int wr, int wc, int fr, int fq) const {
        const int row0 = u.pm * 256 + wr * 64 + fr;
        if (u.pn * 256 < 1152) {
            const int jq = ((32 * wc + 8 * fq) & 63) >> 3, d0 = 4 * jq;
#pragma unroll
            for (int bj = 0; bj < 2; ++bj) {
                const int zc = u.pn * 256 + bj * 128;
                if (zc >= 1152) {
                    const int cc = wc * 32 + 8 * fq; const f32x4 b0 = *(const f32x4*)(bias + zc + cc), b1 = *(const f32x4*)(bias + zc + cc + 4);
#pragma unroll
                    for (int ai = 0; ai < 2; ++ai)
#pragma unroll
                        for (int m = 0; m < 4; ++m) { const f32x4 v0 = acc[ai][bj][m][0] * SC + b0, v1 = acc[ai][bj][m][1] * SC + b1;
                            v4u w; w.x = pg8::cvt_pk_bf16(v0[0], v0[1]); w.y = pg8::cvt_pk_bf16(v0[2], v0[3]); w.z = pg8::cvt_pk_bf16(v1[0], v1[1]); w.w = pg8::cvt_pk_bf16(v1[2], v1[3]);
                            *(v4u*)(V + (size_t)(row0 + ai * 128 + m * 16) * 128 + cc) = w; }
                } else {
                    const bool isq = zc < 1024; bf16* dst = isq ? Q : K; const int ld = isq ? 1024 : 128; const int cc = (isq ? zc : 0) + wc * 32 + 8 * fq;
                    const int hb = (zc + wc * 32 + 8 * fq) & ~63;
                    const f32x4 b0 = *(const f32x4*)(bias + hb + d0), b1 = *(const f32x4*)(bias + hb + 32 + d0);
                    const float qs = isq ? 0.125f * 1.4426950408889634f : 1.0f;
#pragma unroll
                    for (int ai = 0; ai < 2; ++ai) {
                        f32x4 ra[4], rb[4];
#pragma unroll
                        for (int m = 0; m < 4; ++m) { const f32x4* rp = (const f32x4*)(rope + (size_t)(row0 + ai * 128 + m * 16) * 32 + d0); ra[m] = rp[0]; rb[m] = rp[1]; }
#pragma unroll
                        for (int m = 0; m < 4; ++m) {
                            const f32x4 x1 = acc[ai][bj][m][0] * SC + b0, x2 = acc[ai][bj][m][1] * SC + b1;
                            const float cs[4] = {ra[m].x, ra[m].z, rb[m].x, rb[m].z}, sn[4] = {ra[m].y, ra[m].w, rb[m].y, rb[m].w};
                            float o1[4], o2[4];
#pragma unroll
                            for (int j = 0; j < 4; ++j) { o1[j] = qs * (x1[j] * cs[j] - x2[j] * sn[j]); o2[j] = qs * (x2[j] * cs[j] + x1[j] * sn[j]); }
                            v4u w; w.x = pg8::cvt_pk_bf16(o1[0], o1[1]); w.y = pg8::cvt_pk_bf16(o1[2], o1[3]); w.z = pg8::cvt_pk_bf16(o2[0], o2[1]); w.w = pg8::cvt_pk_bf16(o2[2], o2[3]);
                            *(v4u*)(dst + (size_t)(row0 + ai * 128 + m * 16) * ld + cc) = w; }
                    }
                }
            }
            return;
        }
        if (u.pn * 256 >= 1792) {
            const int c = ((u.pn * 256 - 1792) >> 8) * 128 + wc * 32 + 8 * fq;
            const float* bp = bias + 1792 + c;
            const f32x4 b00 = *(const f32x4*)bp, b01 = *(const f32x4*)(bp + 4), b10 = *(const f32x4*)(bp + 1024), b11 = *(const f32x4*)(bp + 1028);
            const float nl = -1.4426950408889634f;
#pragma unroll
            for (int ai = 0; ai < 2; ++ai)
#pragma unroll
                for (int m = 0; m < 4; ++m) {
                    const f32x4 z0[2] = {acc[ai][0][m][0] * SC + b00, acc[ai][0][m][1] * SC + b01}, z1[2] = {acc[ai][1][m][0] * SC + b10, acc[ai][1][m][1] * SC + b11};
                    float rho[8], g1v[8];
#pragma unroll
                    for (int h = 0; h < 2; ++h)
#pragma unroll
                        for (int j = 0; j < 4; ++j) { const float d0 = 1.0f + __builtin_amdgcn_exp2f(nl * z0[h][j]), d1 = 1.0f + __builtin_amdgcn_exp2f(nl * z1[h][j]);
                            g1v[4 * h + j] = __builtin_amdgcn_rcpf(d1); rho[4 * h + j] = d1 * __builtin_amdgcn_rcpf(d0); }
                    bf16* gp = G + (size_t)(row0 + ai * 128 + m * 16) * 2048 + c;
                    v4u w; w.x = pg8::cvt_pk_bf16(rho[0], rho[1]); w.y = pg8::cvt_pk_bf16(rho[2], rho[3]); w.z = pg8::cvt_pk_bf16(rho[4], rho[5]); w.w = pg8::cvt_pk_bf16(rho[6], rho[7]);
                    *(v4u*)gp = w;
                    w.x = pg8::cvt_pk_bf16(g1v[0], g1v[1]); w.y = pg8::cvt_pk_bf16(g1v[2], g1v[3]); w.z = pg8::cvt_pk_bf16(g1v[4], g1v[5]); w.w = pg8::cvt_pk_bf16(g1v[6], g1v[7]);
                    *(v4u*)(gp + 1024) = w; }
            return;
        }
#pragma unroll
        for (int bj = 0; bj < 2; ++bj) {
            const int zc = u.pn * 256 + bj * 128; const int cc = zc - 1280 + wc * 32 + 8 * fq;
            const float* bp = bias + zc + wc * 32 + 8 * fq; const f32x4 b0 = *(const f32x4*)bp, b1 = *(const f32x4*)(bp + 4);
#pragma unroll
            for (int ai = 0; ai < 2; ++ai)
#pragma unroll
                for (int m = 0; m < 4; ++m) {
                    const f32x4 v0 = acc[ai][bj][m][0] * SC + b0, v1 = acc[ai][bj][m][1] * SC + b1;
                    v4u w; w.x = pg8::cvt_pk_bf16(v0[0], v0[1]); w.y = pg8::cvt_pk_bf16(v0[2], v0[3]); w.z = pg8::cvt_pk_bf16(v1[0], v1[1]); w.w = pg8::cvt_pk_bf16(v1[2], v1[3]);
                    *(v4u*)(U + (size_t)(row0 + ai * 128 + m * 16) * 512 + cc) = w; }
        }
    }
};

struct PolP3 {
    static constexpr bool FP8 = false, UNIFORM_A = false, UNIFORM_B = false;
    static constexpr bool PERM = true;
    const char *A0, *B0, *A1, *B1; const float* bo; const bf16* G; bf16* O; int G_, c;
    __device__ __forceinline__ bool next(int i, pg8::Unit& u) const {
        int pm, pn; if (!pg8::tile_order(NTOK / 256, D / 256, G_, c, i >> 1, pm, pn)) return false;
        u.pm = pm; u.pn = pn; u.kind = i & 1; u.e = 0; u.r0 = 0; u.aux = 0;
        if (u.kind == 0) { u.A = A0 + (size_t)pm * 256 * 2048; u.B = B0 + (size_t)pn * 256 * 2048; u.nt = 16; u.ldb = 2048; }
        else { u.A = A1 + (size_t)pm * 256 * 1024; u.B = B1 + (size_t)pn * 256 * 1024; u.nt = 8; u.ldb = 1024; }
        return true; }
    __device__ __forceinline__ void lane_issue(const pg8::Unit&, int, int (&)[2][2]) const {}
    __device__ __forceinline__ void lane_issue_asm(const pg8::Unit&, int, int (&)[2][2]) const {}
    __device__ __forceinline__ void lane_finish(const pg8::Unit& u, int tid_, const int (&)[2][2], unsigned (&va)[2][2]) const {
        int R[2], C2[2];
#pragma unroll
        for (int i_ = 0; i_ < 2; ++i_) { int C_; pg8::stage_rc(tid_ * 16 + i_ * 8192, R[i_], C_); C2[i_] = C_ * 2; }
        const int lda = u.kind == 0 ? 2048 : 1024;
#pragma unroll
        for (int h = 0; h < 2; ++h) { va[h][0] = (unsigned)((R[0] + 128 * h) * lda + C2[0]); va[h][1] = (unsigned)((R[1] + 128 * h) * lda + C2[1]); } }
    __device__ __forceinline__ bool keep_acc(const pg8::Unit& u) const { return u.kind == 0; }
    __device__ __forceinline__ void epilogue(f32x4 (&acc)[2][2][4][2], const pg8::Unit& u, int wr, int wc, int fr, int fq) const {
        const int row0 = u.pm * 256 + wr * 64 + fr;
        const int cc0 = u.pn * 256 + wc * 32 + 8 * fq;
        if (u.kind == 0) {
            f32x4 bb[2][2];
#pragma unroll
            for (int bj = 0; bj < 2; ++bj) { bb[bj][0] = *(const f32x4*)(bo + cc0 + bj * 128); bb[bj][1] = *(const f32x4*)(bo + cc0 + bj * 128 + 4); }
#pragma unroll
            for (int ai = 0; ai < 2; ++ai) {
                v4u g0[4][2];
#pragma unroll
                for (int m = 0; m < 4; ++m)
#pragma unroll
                    for (int bj = 0; bj < 2; ++bj) g0[m][bj] = *(const v4u*)(G + (size_t)(row0 + ai * 128 + m * 16) * 2048 + cc0 + bj * 128);
#pragma unroll
                for (int m = 0; m < 4; ++m)
#pragma unroll
                    for (int bj = 0; bj < 2; ++bj) {
                        const v4u a0 = g0[m][bj];
                        f32x4 v0 = acc[ai][bj][m][0] + bb[bj][0], v1 = acc[ai][bj][m][1] + bb[bj][1];
                        v0[0] *= bflo(a0.x); v0[1] *= bfhi(a0.x); v0[2] *= bflo(a0.y); v0[3] *= bfhi(a0.y);
                        v1[0] *= bflo(a0.z); v1[1] *= bfhi(a0.z); v1[2] *= bflo(a0.w); v1[3] *= bfhi(a0.w);
                        acc[ai][bj][m][0] = v0; acc[ai][bj][m][1] = v1; }
            }
        } else {
            v4u g1[2][4][2];
#pragma unroll
            for (int ai = 0; ai < 2; ++ai)
#pragma unroll
                for (int m = 0; m < 4; ++m)
#pragma unroll
                    for (int bj = 0; bj < 2; ++bj) g1[ai][m][bj] = *(const v4u*)(G + (size_t)(row0 + ai * 128 + m * 16) * 2048 + 1024 + cc0 + bj * 128);
#pragma unroll
            for (int ai = 0; ai < 2; ++ai)
#pragma unroll
                for (int m = 0; m < 4; ++m)
#pragma unroll
                    for (int bj = 0; bj < 2; ++bj) {
                        const v4u a1 = g1[ai][m][bj];
                        const f32x4 v0 = acc[ai][bj][m][0], v1 = acc[ai][bj][m][1];
                        v4u w; w.x = pg8::cvt_pk_bf16(v0[0] * bflo(a1.x), v0[1] * bfhi(a1.x)); w.y = pg8::cvt_pk_bf16(v0[2] * bflo(a1.y), v0[3] * bfhi(a1.y));
                        w.z = pg8::cvt_pk_bf16(v1[0] * bflo(a1.z), v1[1] * bfhi(a1.z)); w.w = pg8::cvt_pk_bf16(v1[2] * bflo(a1.w), v1[3] * bfhi(a1.w));
                        *(v4u*)(O + (size_t)(row0 + ai * 128 + m * 16) * 1024 + cc0 + bj * 128) = w; }
        }
    }
};

struct PolP4 {
    static constexpr bool FP8 = false, UNIFORM_A = true, UNIFORM_B = true;
    static constexpr bool PERM = true;
    const char* A; const char* B; const float* x; bf16* out; float* ssp; int G_, c;
    __device__ __forceinline__ bool next(int i, pg8::Unit& u) const {
        int pm, pn; if (!pg8::tile_order(NTOK / 256, D / 256, G_, c, i, pm, pn)) return false;
        u.pm = pm; u.pn = pn; u.A = A + (size_t)pm * 256 * 2048; u.B = B + (size_t)pn * 256 * 2048; u.nt = 16; u.ldb = 2048; u.kind = 0; u.e = 0; u.r0 = 0; u.aux = 0; return true; }
    __device__ __forceinline__ void lane_issue(const pg8::Unit&, int, int (&)[2][2]) const {}
    __device__ __forceinline__ void lane_issue_asm(const pg8::Unit&, int, int (&)[2][2]) const {}
    __device__ __forceinline__ void lane_finish(const pg8::Unit&, int tid_, const int (&)[2][2], unsigned (&va)[2][2]) const {
        int R[2], C2[2];
#pragma unroll
        for (int i_ = 0; i_ < 2; ++i_) { int C_; pg8::stage_rc(tid_ * 16 + i_ * 8192, R[i_], C_); C2[i_] = C_ * 2; }
#pragma unroll
        for (int h = 0; h < 2; ++h) { va[h][0] = (unsigned)((R[0] + 128 * h) * 2048 + C2[0]); va[h][1] = (unsigned)((R[1] + 128 * h) * 2048 + C2[1]); } }
    __device__ __forceinline__ bool keep_acc(const pg8::Unit&) const { return false; }
    __device__ __forceinline__ void epilogue(f32x4 (&acc)[2][2][4][2], const pg8::Unit& u, int wr, int wc, int fr, int fq) const {
        const int row0 = u.pm * 256 + wr * 64 + fr, col0 = u.pn * 256 + wc * 32 + 8 * fq;
#pragma unroll
        for (int ai = 0; ai < 2; ++ai) {
            f32x4 xv[4][2][2];
#pragma unroll
            for (int m = 0; m < 4; ++m)
#pragma unroll
                for (int bj = 0; bj < 2; ++bj)
#pragma unroll
                    for (int n = 0; n < 2; ++n) xv[m][bj][n] = *(const f32x4*)(x + (size_t)(row0 + ai * 128 + m * 16) * D + col0 + bj * 128 + n * 4);
#pragma unroll
            for (int m = 0; m < 4; ++m) { const size_t off = (size_t)(row0 + ai * 128 + m * 16) * D + col0; float ss = 0.f;
#pragma unroll
                for (int bj = 0; bj < 2; ++bj) { const f32x4 o0 = acc[ai][bj][m][0] + xv[m][bj][0], o1 = acc[ai][bj][m][1] + xv[m][bj][1];
                    ss += ((o0[0] * o0[0] + o0[1] * o0[1]) + (o0[2] * o0[2] + o0[3] * o0[3])) + ((o1[0] * o1[0] + o1[1] * o1[1]) + (o1[2] * o1[2] + o1[3] * o1[3]));
                    v4u w; w.x = pg8::cvt_pk_bf16(o0[0], o0[1]); w.y = pg8::cvt_pk_bf16(o0[2], o0[3]); w.z = pg8::cvt_pk_bf16(o1[0], o1[1]); w.w = pg8::cvt_pk_bf16(o1[2], o1[3]);
                    *(v4u*)(out + off + bj * 128) = w; }
                ss += __shfl_xor(ss, 16); ss += __shfl_xor(ss, 32);
                if (fq == 0) ssp[(size_t)(row0 + ai * 128 + m * 16) * 16 + u.pn * 4 + wc] = ss; }
        }
    }
};

__device__ __forceinline__ unsigned pk4_fp8(float a, float b, float c, float d) { int w = __builtin_amdgcn_cvt_pk_fp8_f32(a, b, 0, false); w = __builtin_amdgcn_cvt_pk_fp8_f32(c, d, w, true); return (unsigned)w; }
struct PolP7 {
    static constexpr bool FP8 = true, UNIFORM_A = false, UNIFORM_B = true;
    static constexpr bool PERM = true;
    const char* H2; const char* W; const int* ltok; const float* bg; const float* bu; unsigned char* a; const LAS int* tab; const LAS unsigned* rbmap; int G_, c;
    __device__ __forceinline__ bool next(int i, pg8::Unit& u) const {
        const int nrb = __builtin_amdgcn_readfirstlane(tab[T_NRBTOT]); int pm, pn; if (!pg8::tile_order(nrb, 8, G_, c, i, pm, pn)) return false;
        const unsigned m = (unsigned)__builtin_amdgcn_readfirstlane((int)rbmap[pm]); const int e = (int)(m >> 16), rb = (int)(m & 0xffffu);
        u.pm = pm; u.pn = pn; u.e = e; u.r0 = rb * 256; u.A = H2; u.B = W + ((size_t)e * 2048 + (size_t)pn * 256) * 1024; u.nt = 8; u.ldb = 1024; u.kind = 0; u.aux = 0; return true; }
    __device__ __forceinline__ void lane_issue(const pg8::Unit& u, int tid_, int (&idx)[2][2]) const {
        int R[2];
#pragma unroll
        for (int i_ = 0; i_ < 2; ++i_) { int C_; pg8::stage_rc(tid_ * 16 + i_ * 8192, R[i_], C_); }
        const int e = u.e, c0 = tab[T_CNT0 + e], c1 = tab[T_CNT1 + e];
#pragma unroll
        for (int h = 0; h < 2; ++h)
#pragma unroll
            for (int i = 0; i < 2; ++i) { const int rr = u.r0 + R[i] + 128 * h; const bool in0 = rr < c0, in1 = rr < c0 + c1;
                int li = in0 ? e * LCAP + rr : (NE + e) * LCAP + (rr - c0); li = in1 ? li : e * LCAP; idx[h][i] = ltok[li]; } }
    __device__ __forceinline__ void lane_issue_asm(const pg8::Unit& u, int tid_, int (&idx)[2][2]) const {
        int R[2];
#pragma unroll
        for (int i_ = 0; i_ < 2; ++i_) { int C_; pg8::stage_rc(tid_ * 16 + i_ * 8192, R[i_], C_); }
        const int e = u.e, c0 = tab[T_CNT0 + e], c1 = tab[T_CNT1 + e];
#pragma unroll
        for (int h = 0; h < 2; ++h)
#pragma unroll
            for (int i = 0; i < 2; ++i) { const int rr = u.r0 + R[i] + 128 * h; const bool in0 = rr < c0, in1 = rr < c0 + c1;
                int li = in0 ? e * LCAP + rr : (NE + e) * LCAP + (rr - c0); li = in1 ? li : e * LCAP; const unsigned boff = (unsigned)li * 4u;
                asm volatile("global_load_dword %0, %1, %2" : "=&v"(idx[h][i]) : "v"(boff), "s"(ltok) : "memory"); } }
    __device__ __forceinline__ void lane_finish(const pg8::Unit& u, int tid_, const int (&idx)[2][2], unsigned (&va)[2][2]) const {
        int R[2], C2[2];
#pragma unroll
        for (int i_ = 0; i_ < 2; ++i_) { int C_; pg8::stage_rc(tid_ * 16 + i_ * 8192, R[i_], C_); C2[i_] = C_ * 2; }
        const int e = u.e, c0 = tab[T_CNT0 + e], c1 = tab[T_CNT1 + e];
#pragma unroll
        for (int h = 0; h < 2; ++h)
#pragma unroll
            for (int i = 0; i < 2; ++i) { const int rr = u.r0 + R[i] + 128 * h; const bool in1 = rr < c0 + c1; va[h][i] = (unsigned)((in1 ? (idx[h][i] >> 2) : 0) * 1024 + C2[i]); } }
    __device__ __forceinline__ bool keep_acc(const pg8::Unit&) const { return false; }
    __device__ __forceinline__ void epilogue(f32x4 (&acc)[2][2][4][2], const pg8::Unit& u, int wr, int wc, int fr, int fq) const {
        const int e = u.e, ps = tab[T_PSTART + e];
        const int ff = u.pn * 128 + wc * 32 + 8 * fq;
        const f32x4 g0 = *(const f32x4*)(bg + e * DFF + ff), g1 = *(const f32x4*)(bg + e * DFF + ff + 4), u0 = *(const f32x4*)(bu + e * DFF + ff), u1 = *(const f32x4*)(bu + e * DFF + ff + 4);
        const f32x2 scg = {1.0f / 64.0f, 1.0f / 64.0f}, scu = {4.0f / 64.0f, 4.0f / 64.0f}, kk = {-1.702f * 1.4426950408889634f, -1.702f * 1.4426950408889634f}, one = {1.0f, 1.0f};
        f32x2 bgp[4], bup[4];
        bgp[0] = (f32x2){g0[0], g0[1]}; bgp[1] = (f32x2){g0[2], g0[3]}; bgp[2] = (f32x2){g1[0], g1[1]}; bgp[3] = (f32x2){g1[2], g1[3]};
        bup[0] = (f32x2){4.f * u0[0] + 4.f, 4.f * u0[1] + 4.f}; bup[1] = (f32x2){4.f * u0[2] + 4.f, 4.f * u0[3] + 4.f}; bup[2] = (f32x2){4.f * u1[0] + 4.f, 4.f * u1[1] + 4.f}; bup[3] = (f32x2){4.f * u1[2] + 4.f, 4.f * u1[3] + 4.f};
#pragma unroll
        for (int ai = 0; ai < 2; ++ai)
#pragma unroll
            for (int mp = 0; mp < 2; ++mp) {
                v2u wq[2];
#pragma unroll
                for (int mm = 0; mm < 2; ++mm) { const int m = 2 * mp + mm;
                    f32x2 o[4];
#pragma unroll
                    for (int q = 0; q < 4; ++q) {
                        const f32x4 ga = acc[ai][0][m][q >> 1], ua = acc[ai][1][m][q >> 1];
                        f32x2 g = (q & 1) ? (f32x2){ga[2], ga[3]} : (f32x2){ga[0], ga[1]}, uu = (q & 1) ? (f32x2){ua[2], ua[3]} : (f32x2){ua[0], ua[1]};
                        g = g * scg + bgp[q]; uu = uu * scu + bup[q];
                        g.x = fminf(g.x, 7.0f); g.y = fminf(g.y, 7.0f);
                        uu.x = __builtin_amdgcn_fmed3f(uu.x, -24.0f, 32.0f); uu.y = __builtin_amdgcn_fmed3f(uu.y, -24.0f, 32.0f);
                        f32x2 t = g * kk; t.x = __builtin_amdgcn_exp2f(t.x); t.y = __builtin_amdgcn_exp2f(t.y);
                        t = t + one; t.x = __builtin_amdgcn_rcpf(t.x); t.y = __builtin_amdgcn_rcpf(t.y);
                        o[q] = (g * t) * uu; }
                    wq[mm].x = pk4_fp8(o[0].x, o[0].y, o[1].x, o[1].y); wq[mm].y = pk4_fp8(o[2].x, o[2].y, o[3].x, o[3].y); }
                const v2u r0 = __builtin_amdgcn_permlane16_swap(wq[0].x, wq[1].x, false, false), r1 = __builtin_amdgcn_permlane16_swap(wq[0].y, wq[1].y, false, false);
                const int rr = u.r0 + ai * 128 + wr * 64 + (2 * mp + (fq & 1)) * 16 + fr;
                *(v4u*)(a + (size_t)(ps + rr) * DFF + (ff - 8 * (fq & 1))) = (v4u){r0.x, r1.x, r0.y, r1.y}; }
    }
};

struct PolP8 {
    static constexpr bool FP8 = true, UNIFORM_A = true, UNIFORM_B = true;
    static constexpr bool PERM = true;
    const char* Aa; const char* W; const int* ltok; const float* bd; unsigned char* Y; const LAS int* tab; const LAS unsigned* rbmap; int G_, c;
    __device__ __forceinline__ bool next(int i, pg8::Unit& u) const {
        const int nrb = __builtin_amdgcn_readfirstlane(tab[T_NRBTOT]); int pm, pn; if (!pg8::tile_order(nrb, 4, G_, c, i, pm, pn)) return false;
        const unsigned m = (unsigned)__builtin_amdgcn_readfirstlane((int)rbmap[pm]); const int e = (int)(m >> 16), rb = (int)(m & 0xffffu);
        const int arow = __builtin_amdgcn_readfirstlane(tab[T_PSTART + e]) + rb * 256;
        u.pm = pm; u.pn = pn; u.e = e; u.r0 = rb * 256; u.A = Aa + (size_t)arow * 1024; u.B = W + ((size_t)e * 1024 + (size_t)pn * 256) * 1024; u.nt = 8; u.ldb = 1024; u.kind = 0; u.aux = 0; return true; }
    __device__ __forceinline__ void lane_issue(const pg8::Unit&, int, int (&)[2][2]) const {}
    __device__ __forceinline__ void lane_issue_asm(const pg8::Unit&, int, int (&)[2][2]) const {}
    __device__ __forceinline__ void lane_finish(const pg8::Unit&, int tid_, const int (&)[2][2], unsigned (&va)[2][2]) const {
        int R[2], C2[2];
#pragma unroll
        for (int i_ = 0; i_ < 2; ++i_) { int C_; pg8::stage_rc(tid_ * 16 + i_ * 8192, R[i_], C_); C2[i_] = C_ * 2; }
#pragma unroll
        for (int h = 0; h < 2; ++h) { va[h][0] = (unsigned)((R[0] + 128 * h) * 1024 + C2[0]); va[h][1] = (unsigned)((R[1] + 128 * h) * 1024 + C2[1]); } }
    __device__ __forceinline__ bool keep_acc(const pg8::Unit&) const { return false; }
    __device__ __forceinline__ void epilogue(f32x4 (&acc)[2][2][4][2], const pg8::Unit& u, int wr, int wc, int fr, int fq) const {
        const int e = u.e, c0 = tab[T_CNT0 + e], c1 = tab[T_CNT1 + e];
        const int cc0 = u.pn * 256 + wc * 32 + 8 * fq;
        f32x4 bb[2][2]; int dstp[2][2];
#pragma unroll
        for (int bj = 0; bj < 2; ++bj) { bb[bj][0] = *(const f32x4*)(bd + e * D + cc0 + bj * 128); bb[bj][1] = *(const f32x4*)(bd + e * D + cc0 + bj * 128 + 4); }
#pragma unroll
        for (int ai = 0; ai < 2; ++ai)
#pragma unroll
            for (int mp = 0; mp < 2; ++mp) { const int rr = u.r0 + ai * 128 + wr * 64 + (2 * mp + (fq & 1)) * 16 + fr; const bool in0 = rr < c0, in1 = rr < c0 + c1;
                int li = in0 ? e * LCAP + rr : (NE + e) * LCAP + (rr - c0); li = in1 ? li : e * LCAP; dstp[ai][mp] = ltok[li]; }
        const float sc = 8.0f / 256.0f;
#pragma unroll
        for (int bj = 0; bj < 2; ++bj) { bb[bj][0] *= 8.0f; bb[bj][1] *= 8.0f; }
#pragma unroll
        for (int ai = 0; ai < 2; ++ai)
#pragma unroll
            for (int mp = 0; mp < 2; ++mp) {
                const int msel = 2 * mp + (fq & 1);
                const int rr = u.r0 + ai * 128 + wr * 64 + msel * 16 + fr;
                const int d_ = dstp[ai][mp];
#pragma unroll
                for (int bj = 0; bj < 2; ++bj) {
                    v2u wq[2];
#pragma unroll
                    for (int mm = 0; mm < 2; ++mm) { const int m = 2 * mp + mm;
                        const f32x4 v0 = acc[ai][bj][m][0] * sc + bb[bj][0], v1 = acc[ai][bj][m][1] * sc + bb[bj][1];
                        wq[mm].x = pk4_fp8(v0[0], v0[1], v0[2], v0[3]); wq[mm].y = pk4_fp8(v1[0], v1[1], v1[2], v1[3]); }
                    const v2u r0 = __builtin_amdgcn_permlane16_swap(wq[0].x, wq[1].x, false, false), r1 = __builtin_amdgcn_permlane16_swap(wq[0].y, wq[1].y, false, false);
                    if (rr < c0 + c1) *(v4u*)(Y + (size_t)d_ * D + cc0 + bj * 128 - 8 * (fq & 1)) = (v4u){r0.x, r1.x, r0.y, r1.y}; }
            }
    }
};

__device__ __forceinline__ float wave_sum(float v) {
#pragma unroll
    for (int o = 1; o < 64; o <<= 1) v += __shfl_xor(v, o);
    return v;
}
__device__ __forceinline__ void transpose_item(const float* W, int K, int N, bf16* WT, int k0, int n0, int drow0, LAS float* scr, int lane) {
#pragma unroll 8
    for (int i = 0; i < 32; ++i) { const int kk = 2 * i + (lane >> 5); scr[kk * 33 + (lane & 31)] = W[(size_t)(k0 + kk) * N + n0 + (lane & 31)]; }
    LDS_WAIT(); asm volatile("" ::: "memory");
    const int c = lane & 7;
#pragma unroll
    for (int j = 0; j < 4; ++j) { const int n = (lane >> 3) + 8 * j; const LAS float* s = scr + (8 * c) * 33 + n;
        v4u o; o.x = pk2(s[0 * 33], s[1 * 33]); o.y = pk2(s[2 * 33], s[3 * 33]); o.z = pk2(s[4 * 33], s[5 * 33]); o.w = pk2(s[6 * 33], s[7 * 33]);
        *(v4u*)(WT + (size_t)(drow0 + n) * K + k0 + 8 * c) = o; }
    LDS_WAIT(); asm volatile("" ::: "memory");
}
__device__ __forceinline__ void transpose_item8(const float* W, int K, int N, unsigned char* WT, int k0, int n0, int drow0, float scale, LAS float* scr, int lane) {
#pragma unroll 8
    for (int i = 0; i < 32; ++i) { const int kk = 2 * i + (lane >> 5); scr[kk * 33 + (lane & 31)] = W[(size_t)(k0 + kk) * N + n0 + (lane & 31)]; }
    LDS_WAIT(); asm volatile("" ::: "memory");
    const int c = lane & 7;
#pragma unroll
    for (int j = 0; j < 4; ++j) { const int n = (lane >> 3) + 8 * j; const LAS float* s = scr + (8 * c) * 33 + n;
        v2u o; o.x = pk4_fp8(s[0 * 33] * scale, s[1 * 33] * scale, s[2 * 33] * scale, s[3 * 33] * scale); o.y = pk4_fp8(s[4 * 33] * scale, s[5 * 33] * scale, s[6 * 33] * scale, s[7 * 33] * scale);
        *(v2u*)(WT + (size_t)(drow0 + n) * K + k0 + 8 * c) = o; }
    LDS_WAIT(); asm volatile("" ::: "memory");
}
__device__ __forceinline__ int qk_perm_d(int p) { const int j = (p >> 3) & 7, i = p & 7; return (p & ~63) + 4 * j + (i & 3) + 32 * (i >> 2); }
__device__ __forceinline__ void transpose_item_qk(const float* W, int K, int N, bf16* WT, int k0, int n0, LAS float* scr, int lane) {
    const int p = n0 + (lane & 31); const int srcc = (n0 < 1152) ? qk_perm_d(p) : p;
#pragma unroll 8
    for (int i = 0; i < 32; ++i) { const int kk = 2 * i + (lane >> 5); scr[kk * 33 + (lane & 31)] = W[(size_t)(k0 + kk) * N + srcc]; }
    LDS_WAIT(); asm volatile("" ::: "memory");
    const int c = lane & 7;
#pragma unroll
    for (int j = 0; j < 4; ++j) { const int n = (lane >> 3) + 8 * j; const LAS float* s = scr + (8 * c) * 33 + n;
        v4u o; o.x = pk2(s[0 * 33], s[1 * 33]); o.y = pk2(s[2 * 33], s[3 * 33]); o.z = pk2(s[4 * 33], s[5 * 33]); o.w = pk2(s[6 * 33], s[7 * 33]);
        *(v4u*)(WT + (size_t)(n0 + n) * K + k0 + 8 * c) = o; }
    LDS_WAIT(); asm volatile("" ::: "memory");
}
__device__ __forceinline__ void transpose_item_qk8(const float* W, int K, int N, unsigned char* WT, int k0, int n0, LAS float* scr, int lane) {
    const int p = n0 + (lane & 31); int srcc = (n0 < 1152) ? qk_perm_d(p) : p;
    if (n0 >= 1792) { const int q = p - 1792; srcc = 1792 + ((q >> 7) & 1) * 1024 + (q >> 8) * 128 + (q & 127); }
#pragma unroll 8
    for (int i = 0; i < 32; ++i) { const int kk = 2 * i + (lane >> 5); scr[kk * 33 + (lane & 31)] = W[(size_t)(k0 + kk) * N + srcc]; }
    LDS_WAIT(); asm volatile("" ::: "memory");
    const int c = lane & 7;
#pragma unroll
    for (int j = 0; j < 4; ++j) { const int n = (lane >> 3) + 8 * j; const LAS float* s = scr + (8 * c) * 33 + n;
        v2u o; o.x = pk4_fp8(s[0 * 33] * 64.f, s[1 * 33] * 64.f, s[2 * 33] * 64.f, s[3 * 33] * 64.f); o.y = pk4_fp8(s[4 * 33] * 64.f, s[5 * 33] * 64.f, s[6 * 33] * 64.f, s[7 * 33] * 64.f);
        *(v2u*)(WT + (size_t)(n0 + n) * K + k0 + 8 * c) = o; }
    LDS_WAIT(); asm volatile("" ::: "memory");
}
__device__ __forceinline__ void transpose_item8w(const float* W, int N, unsigned char* WT, int k0, int n0, int drow0, float scale, LAS float* scr, int lane) {
#pragma unroll 16
    for (int i = 0; i < 64; ++i) { const int kk = 2 * i + (lane >> 5); scr[kk * 33 + (lane & 31)] = W[(size_t)(k0 + kk) * N + n0 + (lane & 31)]; }
    LDS_WAIT(); asm volatile("" ::: "memory");
    const int c = lane & 7;
#pragma unroll
    for (int j = 0; j < 4; ++j) { const int n = (lane >> 3) + 8 * j; const LAS float* s = scr + (16 * c) * 33 + n;
        v4u o; o.x = pk4_fp8(s[0 * 33] * scale, s[1 * 33] * scale, s[2 * 33] * scale, s[3 * 33] * scale); o.y = pk4_fp8(s[4 * 33] * scale, s[5 * 33] * scale, s[6 * 33] * scale, s[7 * 33] * scale);
        o.z = pk4_fp8(s[8 * 33] * scale, s[9 * 33] * scale, s[10 * 33] * scale, s[11 * 33] * scale); o.w = pk4_fp8(s[12 * 33] * scale, s[13 * 33] * scale, s[14 * 33] * scale, s[15 * 33] * scale);
        *(v4u*)(WT + (size_t)(drow0 + n) * 1024 + k0 + 16 * c) = o; }
    LDS_WAIT(); asm volatile("" ::: "memory");
}
__device__ __forceinline__ void transpose_mat(const float* W, int K, int N, bf16* WT, int item, LAS float* scr, int lane) {
    const int nblk = N / 32, kb = item / nblk, nb = item % nblk;
    transpose_item(W, K, N, WT, 64 * kb, 32 * nb, 32 * nb, scr, lane);
}

template <class R> __device__ __forceinline__ void conv_run(const Ptrs& P, LAS unsigned char* lds, int wave, int lane, int G, R&& released);
__device__ __forceinline__ void p0_prologue(const Ptrs& P, LAS unsigned char* lds, int wave, int lane, int G) {
    LAS float* scr = (LAS float*)(lds + wave * 17408);
    unsigned char* ws = P.ws;
    constexpr int I_IN = (D / 64) * (INW / 32), I_O = (D / 64) * (D / 32), I_UP = (POOLW / 64) * (D / 32), I_OUT = I_O, I_MIX = 4 * (128 / 64) * (128 / 32);
    constexpr int NITEMS = I_IN + I_O + I_UP + I_OUT + I_MIX;
    LAS int* rowctr = (LAS int*)(lds + MISC_OFF + 64);
    if (wave >= 4) {
        const int gw = blockIdx.x * 4 + (wave - 4), NGW = G * 4;
        for (int it = gw; it < NITEMS; it += NGW) {
            int r = it;
            if (r < I_IN) { const int nblk = INW / 32, kb = r / nblk, nb = r % nblk; transpose_item_qk8(P.w_in, D, INW, ws + WS_WIN, 64 * kb, 32 * nb, scr, lane); continue; } r -= I_IN;
            if (r < I_O) { transpose_mat(P.w_o, D, D, (bf16*)(ws + WS_WO), r, scr, lane); continue; } r -= I_O;
            if (r < I_UP) { transpose_mat(P.w_pool_up, POOLW, D, (bf16*)(ws + WS_WUP), r, scr, lane); continue; } r -= I_UP;
            if (r < I_OUT) { transpose_mat(P.w_out, D, D, (bf16*)(ws + WS_WOUT), r, scr, lane); continue; } r -= I_OUT;
            { const int g = r / 8, q = r % 8; transpose_mat(P.w_pool_mix + (size_t)g * 128 * 128, 128, 128, (bf16*)(ws + WS_WMIX) + (size_t)g * 128 * 128, q, scr, lane); }
        }
        for (int i = gw * 64 + lane; i < D * NE; i += NGW * 64) { const int e = i / D, k = i % D; const float w = P.w_router[(size_t)k * NE + e];
            const unsigned hi = f2bf(w); const float lo = w - __builtin_bit_cast(float, hi << 16);
            ((bf16*)(ws + WS_WRHI))[i] = (bf16)hi; ((bf16*)(ws + WS_WRLO))[i] = (bf16)f2bf(lo); }
        for (int i = gw * 64 + lane; i < NTOK * 32; i += NGW * 64) { const int tok = i >> 5, fi = i & 31;
            const float inv_freq = powf(10000.0f, -(float)(2 * fi) / 64.0f);
            const float ang = (float)P.positions[tok] * inv_freq;
            double rev = (double)ang * 0.15915494309189535; rev -= rint(rev);
            const float rf = (float)rev;
            f32x2 cs; cs.x = __builtin_amdgcn_cosf(rf); cs.y = __builtin_amdgcn_sinf(rf);
            ((f32x2*)(ws + WS_ROPE))[i] = cs; }
        { const int ngb = (int)(((long)(NTOK / 4) * (blockIdx.x + 1)) / G) - (int)(((long)(NTOK / 4) * blockIdx.x) / G);
          conv_run(P, lds, wave, lane, G, [&]() { return *(volatile LAS int*)rowctr >= ngb; }); }
    }
    unsigned char* H = ws + WS_RA;
    const f32x4* gr = (const f32x4*)P.norm_mix_g + lane;
    f32x4 gg[4];
#pragma unroll
    for (int j = 0; j < 4; ++j) gg[j] = gr[64 * j];
    constexpr int NGRP = NTOK / 4;
    const int g_lo = (int)(((long)NGRP * blockIdx.x) / G), g_hi = (int)(((long)NGRP * (blockIdx.x + 1)) / G);
    auto grab = [&]() { int j = 0; if (lane == 0) j = __hip_atomic_fetch_add(rowctr, 1, __ATOMIC_RELAXED, __HIP_MEMORY_SCOPE_WORKGROUP); const int g_ = g_lo + __builtin_amdgcn_readfirstlane(j); return g_ < g_hi ? g_ : NGRP; };
    int grp = grab();
    f32x4 v[4][4];
    { const int m0 = grp < NGRP ? grp * 4 : 0;
#pragma unroll
      for (int r = 0; r < 4; ++r) { const f32x4* xr = (const f32x4*)(P.x + (size_t)(m0 + r) * D) + lane;
#pragma unroll
          for (int j = 0; j < 4; ++j) v[r][j] = xr[64 * j]; } }
    while (grp < NGRP) {
        const int m0 = grp * 4;
        const int gn = grab();
        f32x4 nv[4][4];
        { const int mn = gn < NGRP ? gn * 4 : m0;
#pragma unroll
          for (int r = 0; r < 4; ++r) { const f32x4* xr = (const f32x4*)(P.x + (size_t)(mn + r) * D) + lane;
#pragma unroll
              for (int j = 0; j < 4; ++j) nv[r][j] = xr[64 * j]; } }
#pragma unroll
        for (int r = 0; r < 4; ++r) { float s = 0.f;
#pragma unroll
            for (int j = 0; j < 4; ++j) s += (v[r][j].x * v[r][j].x + v[r][j].y * v[r][j].y) + (v[r][j].z * v[r][j].z + v[r][j].w * v[r][j].w);
            const float rstd = 1.0f / sqrtf(wave_sum(s) * (1.f / D) + RMS_EPS);
            unsigned* o8 = (unsigned*)(H + (size_t)(m0 + r) * D) + lane;
#pragma unroll
            for (int j = 0; j < 4; ++j) { const f32x4 g = gg[j]; o8[64 * j] = pk4_fp8(v[r][j].x * rstd * g.x, v[r][j].y * rstd * g.y, v[r][j].z * rstd * g.z, v[r][j].w * rstd * g.w); } }
#pragma unroll
        for (int r = 0; r < 4; ++r)
#pragma unroll
            for (int j = 0; j < 4; ++j) v[r][j] = nv[r][j];
        grp = gn;
    }
}

constexpr int AT_KSTR = 72, AT_VRS = 160, AT_NK = 208;
constexpr int AT_VOFF = 30720, AT_BUF = 64000;
static_assert(AT_NK * AT_KSTR * 2 <= AT_VOFF && AT_VOFF + AT_NK * AT_VRS <= AT_BUF && 2 * AT_BUF <= RING_BYTES, "attn lds");
__device__ __forceinline__ void attn_prefetch(const bf16* Kg, const bf16* Vg, int unit, int tid, v4u (&kr)[4], v4u (&vr)[4]) {
    const int qt64 = unit % (SEQ / 64), kvh = (unit / (SEQ / 64)) % NKVH, b = unit / ((SEQ / 64) * NKVH);
    const int t0 = qt64 * 64, tokbase = b * SEQ;
#pragma unroll
    for (int i = 0; i < 4; ++i) { const int task = tid + 512 * i; const int kl = task >> 3, ds = task & 7, sk = t0 - 128 + kl;
        const bool ok = (task < AT_NK * 8) && (sk >= 0) && (kl < 192);
        const size_t off = (size_t)(tokbase + (ok ? sk : 0)) * 128 + kvh * 64 + 8 * ds;
        const v4u kk = *(const v4u*)(Kg + off), vv = *(const v4u*)(Vg + off);
        kr[i] = ok ? kk : (v4u){0u, 0u, 0u, 0u}; vr[i] = ok ? vv : (v4u){0u, 0u, 0u, 0u}; }
}
#define AT_TR8(o, addr, OFF) asm volatile( \
    "ds_read_b64_tr_b16 %0, %8 offset:%9\n\tds_read_b64_tr_b16 %1, %8 offset:%10\n\tds_read_b64_tr_b16 %2, %8 offset:%11\n\tds_read_b64_tr_b16 %3, %8 offset:%12\n\t" \
    "ds_read_b64_tr_b16 %4, %8 offset:%13\n\tds_read_b64_tr_b16 %5, %8 offset:%14\n\tds_read_b64_tr_b16 %6, %8 offset:%15\n\tds_read_b64_tr_b16 %7, %8 offset:%16\n\ts_waitcnt lgkmcnt(0)" \
    : "=&v"(o[0][0]), "=&v"(o[0][1]), "=&v"(o[1][0]), "=&v"(o[1][1]), "=&v"(o[2][0]), "=&v"(o[2][1]), "=&v"(o[3][0]), "=&v"(o[3][1]) \
    : "v"(addr), "n"((OFF)), "n"((OFF) + 2560), "n"((OFF) + 32), "n"((OFF) + 2560 + 32), "n"((OFF) + 64), "n"((OFF) + 2560 + 64), "n"((OFF) + 96), "n"((OFF) + 2560 + 96) : "memory")
__device__ __forceinline__ void attn_phase(const Ptrs& P, LAS unsigned char* lds, int tid, int wave, int lane, int G) {
    const unsigned char* ws = P.ws;
    const bf16* Qg = (const bf16*)(ws + WS_Q); const bf16* Kg = (const bf16*)(ws + WS_K); const bf16* Vg = (const bf16*)(ws + WS_V);
    bf16* Og = (bf16*)(ws + WS_RA);
    constexpr int NU = NB * NKVH * (SEQ / 64);
    int unit = blockIdx.x; if (unit >= NU) return;
    v4u kr[4], vr[4];
    attn_prefetch(Kg, Vg, unit, tid, kr, vr);
    int buf = 0;
    const int c = lane & 15, g = lane >> 4;
    const float NEG = -__builtin_inff();
    for (; unit < NU; unit += G) {
        const int qt64 = unit % (SEQ / 64), kvh = (unit / (SEQ / 64)) % NKVH, b = unit / ((SEQ / 64) * NKVH);
        const int t0 = qt64 * 64, tokbase = b * SEQ;
        LAS bf16* Kl = (LAS bf16*)(lds + buf * AT_BUF); LAS unsigned char* Vl = lds + buf * AT_BUF + AT_VOFF;
        const int hq = kvh * 8 + wave;
        const bf16* qp0 = Qg + (size_t)(tokbase + t0 + c) * 1024 + hq * 64 + 8 * g;
        bf16x8 nq0 = *(const bf16x8*)qp0, nq1 = *(const bf16x8*)(qp0 + 32);
#pragma unroll
        for (int i = 0; i < 4; ++i) { const int task = tid + 512 * i; const int kl = task >> 3, ds = task & 7;
            if (task < AT_NK * 8) { *(LAS v4u*)(Kl + kl * AT_KSTR + 8 * ds) = kr[i]; *(LAS v4u*)(Vl + kl * AT_VRS + 16 * ds) = vr[i]; } }
        if (unit + G < NU) attn_prefetch(Kg, Vg, unit + G, tid, kr, vr);
        asm volatile("s_waitcnt lgkmcnt(0)" ::: "memory"); __builtin_amdgcn_s_barrier(); asm volatile("" ::: "memory");
        const float sink = P.sinks[hq] * 1.4426950408889634f;
        const unsigned vaddr0 = (unsigned)(size_t)Vl + (unsigned)((4 * g + ((lane & 15) >> 2)) * AT_VRS + 8 * (lane & 3));
        bf16x8 nb0 = *(const bf16x8*)(qp0 + (size_t)16 * 1024), nb1 = *(const bf16x8*)(qp0 + (size_t)16 * 1024 + 32);
#pragma unroll 1
        for (int pq = 0; pq < 2; ++pq) {
            const int qa = 2 * pq;
            const int toka = tokbase + t0 + 16 * qa + c;
            const bf16x8 a0 = nq0, a1 = nq1, b0 = nb0, b1 = nb1;
            { const int qn = pq < 1 ? 2 : 3; const bf16* qp = qp0 + (size_t)(16 * qn) * 1024; nq0 = *(const bf16x8*)qp; nq1 = *(const bf16x8*)(qp + 32);
              nb0 = *(const bf16x8*)(qp + (size_t)16 * 1024 * (pq < 1 ? 1 : 0)); nb1 = *(const bf16x8*)(qp + (size_t)16 * 1024 * (pq < 1 ? 1 : 0) + 32); }
            f32x4 Sa[9], Sb[9];
#pragma unroll
            for (int u = 0; u < 10; ++u) {
                const LAS bf16* kp = Kl + (16 * (qa + u) + c) * AT_KSTR + 8 * g;
                const bf16x8 kf0 = *(const LAS bf16x8*)kp, kf1 = *(const LAS bf16x8*)(kp + 32);
                if (u < 9) { f32x4 sacc = {0.f, 0.f, 0.f, 0.f};
                    sacc = __builtin_amdgcn_mfma_f32_16x16x32_bf16(kf0, a0, sacc, 0, 0, 0); sacc = __builtin_amdgcn_mfma_f32_16x16x32_bf16(kf1, a1, sacc, 0, 0, 0); Sa[u] = sacc; }
                if (u > 0) { f32x4 sacc = {0.f, 0.f, 0.f, 0.f};
                    sacc = __builtin_amdgcn_mfma_f32_16x16x32_bf16(kf0, b0, sacc, 0, 0, 0); sacc = __builtin_amdgcn_mfma_f32_16x16x32_bf16(kf1, b1, sacc, 0, 0, 0); Sb[u - 1] = sacc; } }
#pragma unroll
            for (int r = 0; r < 4; ++r) { const bool lo = (c - 4 * g - r) < 0; Sa[0][r] = lo ? Sa[0][r] : NEG; Sa[8][r] = lo ? NEG : Sa[8][r]; Sb[0][r] = lo ? Sb[0][r] : NEG; Sb[8][r] = lo ? NEG : Sb[8][r]; }
            if (t0 < 128) {
#pragma unroll
                for (int tt = 0; tt < 9; ++tt)
#pragma unroll
                    for (int r = 0; r < 4; ++r) { const int sk = t0 - 128 + 16 * (qa + tt) + 4 * g + r; Sa[tt][r] = sk >= 0 ? Sa[tt][r] : NEG; Sb[tt][r] = (sk + 16) >= 0 ? Sb[tt][r] : NEG; } }
            float mxa = sink, mxb = sink;
#pragma unroll
            for (int tt = 0; tt < 9; ++tt) { mxa = fmaxf(fmaxf(mxa, fmaxf(Sa[tt][0], Sa[tt][1])), fmaxf(Sa[tt][2], Sa[tt][3])); mxb = fmaxf(fmaxf(mxb, fmaxf(Sb[tt][0], Sb[tt][1])), fmaxf(Sb[tt][2], Sb[tt][3])); }
            mxa = fmaxf(mxa, __shfl_xor(mxa, 16)); mxa = fmaxf(mxa, __shfl_xor(mxa, 32)); mxb = fmaxf(mxb, __shfl_xor(mxb, 16)); mxb = fmaxf(mxb, __shfl_xor(mxb, 32));
            float suma = 0.f, sumb = 0.f;
#pragma unroll
            for (int tt = 0; tt < 9; ++tt)
#pragma unroll
                for (int r = 0; r < 4; ++r) { const float pa = __builtin_amdgcn_exp2f(Sa[tt][r] - mxa); Sa[tt][r] = pa; suma += pa; const float pb = __builtin_amdgcn_exp2f(Sb[tt][r] - mxb); Sb[tt][r] = pb; sumb += pb; }
            suma += __shfl_xor(suma, 16); suma += __shfl_xor(suma, 32); sumb += __shfl_xor(sumb, 16); sumb += __shfl_xor(sumb, 32);
            suma += __builtin_amdgcn_exp2f(sink - mxa); sumb += __builtin_amdgcn_exp2f(sink - mxb);
            const float inva = 1.0f / suma, invb = 1.0f / sumb;
            f32x4 Oa[4], Ob[4];
#pragma unroll
            for (int dt = 0; dt < 4; ++dt) { Oa[dt] = (f32x4){0.f, 0.f, 0.f, 0.f}; Ob[dt] = (f32x4){0.f, 0.f, 0.f, 0.f}; }
            const unsigned vaddr = vaddr0 + (unsigned)(qa * 16 * AT_VRS);
#define AT_PK(x) pg8::cvt_pk_bf16((x)[0], (x)[1]), pg8::cvt_pk_bf16((x)[2], (x)[3])
#define AT_PV(ps) do { v2u vv[4][2]; AT_TR8(vv, vaddr, (ps) * 5120); \
                v4u pwa, pwb; { const unsigned t_[2] = {AT_PK(Sa[2 * (ps)])}; pwa.x = t_[0]; pwa.y = t_[1]; } \
                if ((ps) < 4) { const unsigned t_[2] = {AT_PK(Sa[(2 * (ps) + 1) % 9])}; pwa.z = t_[0]; pwa.w = t_[1]; } else { pwa.z = 0u; pwa.w = 0u; } \
                if ((ps) > 0) { const unsigned t_[2] = {AT_PK(Sb[(2 * (ps) + 8) % 9])}; pwb.x = t_[0]; pwb.y = t_[1]; } else { pwb.x = 0u; pwb.y = 0u; } \
                { const unsigned t_[2] = {AT_PK(Sb[2 * (ps)])}; pwb.z = t_[0]; pwb.w = t_[1]; } \
                const bf16x8 pfa = __builtin_bit_cast(bf16x8, pwa), pfb = __builtin_bit_cast(bf16x8, pwb); \
                _Pragma("unroll") for (int dt = 0; dt < 4; ++dt) { const bf16x8 vf = __builtin_bit_cast(bf16x8, (v4u){vv[dt][0].x, vv[dt][0].y, vv[dt][1].x, vv[dt][1].y}); \
                    Oa[dt] = __builtin_amdgcn_mfma_f32_16x16x32_bf16(vf, pfa, Oa[dt], 0, 0, 0); Ob[dt] = __builtin_amdgcn_mfma_f32_16x16x32_bf16(vf, pfb, Ob[dt], 0, 0, 0); } } while (0)
            AT_PV(0); AT_PV(1); AT_PV(2); AT_PV(3); AT_PV(4);
#undef AT_PV
#undef AT_PK
#pragma unroll
            for (int dp = 0; dp < 2; ++dp) {
                v2u xa, ya, xb, yb;
                xa.x = pg8::cvt_pk_bf16(Oa[2 * dp][0] * inva, Oa[2 * dp][1] * inva); xa.y = pg8::cvt_pk_bf16(Oa[2 * dp][2] * inva, Oa[2 * dp][3] * inva);
                ya.x = pg8::cvt_pk_bf16(Oa[2 * dp + 1][0] * inva, Oa[2 * dp + 1][1] * inva); ya.y = pg8::cvt_pk_bf16(Oa[2 * dp + 1][2] * inva, Oa[2 * dp + 1][3] * inva);
                xb.x = pg8::cvt_pk_bf16(Ob[2 * dp][0] * invb, Ob[2 * dp][1] * invb); xb.y = pg8::cvt_pk_bf16(Ob[2 * dp][2] * invb, Ob[2 * dp][3] * invb);
                yb.x = pg8::cvt_pk_bf16(Ob[2 * dp + 1][0] * invb, Ob[2 * dp + 1][1] * invb); yb.y = pg8::cvt_pk_bf16(Ob[2 * dp + 1][2] * invb, Ob[2 * dp + 1][3] * invb);
                const v2u a0_ = __builtin_amdgcn_permlane16_swap(xa.x, ya.x, false, false), a1_ = __builtin_amdgcn_permlane16_swap(xa.y, ya.y, false, false);
                const v2u b0_ = __builtin_amdgcn_permlane16_swap(xb.x, yb.x, false, false), b1_ = __builtin_amdgcn_permlane16_swap(xb.y, yb.y, false, false);
                const int dcol = hq * 64 + 16 * (2 * dp + (g & 1)) + 4 * (g & ~1);
                *(v4u*)(Og + (size_t)toka * 1024 + dcol) = (v4u){a0_.x, a1_.x, a0_.y, a1_.y};
                *(v4u*)(Og + (size_t)(toka + 16) * 1024 + dcol) = (v4u){b0_.x, b1_.x, b0_.y, b1_.y}; }
        }
        buf ^= 1;
    }
    asm volatile("s_waitcnt vmcnt(0) lgkmcnt(0)" ::: "memory"); __builtin_amdgcn_s_barrier(); asm volatile("" ::: "memory");
}
#undef AT_TR8

constexpr int PL_PSTR = 520;
template <int W>
__device__ __forceinline__ void pool_load(unsigned (&raw)[31], const bf16* Ug, int unit, int cp, int th) {
    const int tok0 = unit * 32, s0 = tok0 % SEQ, i0 = 16 * th;
#pragma unroll
    for (int j = 0; j < 15 + W; ++j) { const int ti = i0 - (W - 1) + j; const bool ok = s0 + ti >= 0;
        const unsigned v = *(const unsigned*)(Ug + (size_t)(tok0 + (ok ? ti : 0)) * 512 + 2 * cp); raw[j] = ok ? v : 0u; }
}
template <int W>
__device__ __forceinline__ void pool_slide(const unsigned (&raw)[31], LAS bf16* pl, int unit, int cp, int th) {
    const int tok0 = unit * 32, s0 = tok0 % SEQ, i0 = 16 * th;
    float sa = 0.f, sb = 0.f;
#pragma unroll
    for (int j = 0; j < W - 1; ++j) { sa += bflo(raw[j]); sb += bfhi(raw[j]); }
#pragma unroll
    for (int i = 0; i < 16; ++i) {
        const float ca = bflo(raw[i + W - 1]), cb = bfhi(raw[i + W - 1]);
        sa += ca; sb += cb;
        const int sp = s0 + i0 + i + 1; const float inv = sp < W ? __builtin_amdgcn_rcpf((float)sp) : (1.0f / (float)W);
        *(LAS unsigned*)(pl + (i0 + i) * PL_PSTR + 2 * cp) = pk2(sa * inv - ca, sb * inv - cb);
        sa -= bflo(raw[i]); sb -= bfhi(raw[i]);
    }
}
#define POOL_DISPATCH(fn, ...) do { if (sgrp == 0) fn<2>(__VA_ARGS__); else if (sgrp == 1) fn<4>(__VA_ARGS__); else if (sgrp == 2) fn<8>(__VA_ARGS__); else fn<16>(__VA_ARGS__); } while (0)
__device__ __forceinline__ void pool_phase(const Ptrs& P, LAS unsigned char* lds, int tid, int wave, int lane, int G) {
    const unsigned char* ws = P.ws;
    const bf16* Ug = (const bf16*)(ws + WS_U); const bf16* Wm = (const bf16*)(ws + WS_WMIX); bf16* Mx = (bf16*)(ws + WS_MIXED);
    constexpr int NU = NTOK / 32;
    int unit = blockIdx.x; if (unit >= NU) return;
    const int cp = tid & 255, th = tid >> 8, sgrp = wave & 3;
    const int grp = wave >> 1, nh = wave & 1, c = lane & 15, g = lane >> 4;
    bf16x8 wf[4][4];
#pragma unroll
    for (int s = 0; s < 4; ++s)
#pragma unroll
        for (int n = 0; n < 4; ++n) wf[s][n] = *(const bf16x8*)(Wm + ((size_t)grp * 128 + 16 * (4 * nh + n) + c) * 128 + 32 * s + 8 * g);
    f32x4 psc[4];
#pragma unroll
    for (int n = 0; n < 4; ++n) psc[n] = *(const f32x4*)(P.pool_scale + 128 * grp + 16 * (4 * nh + n) + 4 * g);
    unsigned raw[31];
    POOL_DISPATCH(pool_load, raw, Ug, unit, cp, th);
    int buf = 0;
    for (; unit < NU; unit += G) {
        LAS bf16* pl = (LAS bf16*)(lds + buf * 34816);
        POOL_DISPATCH(pool_slide, raw, pl, unit, cp, th);
        if (unit + G < NU) POOL_DISPATCH(pool_load, raw, Ug, unit + G, cp, th);
        asm volatile("s_waitcnt lgkmcnt(0)" ::: "memory"); __builtin_amdgcn_s_barrier(); asm volatile("" ::: "memory");
        const int tok0 = unit * 32;
        f32x4 acc[2][4];
#pragma unroll
        for (int mt = 0; mt < 2; ++mt)
#pragma unroll
            for (int n = 0; n < 4; ++n) acc[mt][n] = (f32x4){0.f, 0.f, 0.f, 0.f};
#pragma unroll
        for (int s = 0; s < 4; ++s) {
            bf16x8 pf[2];
#pragma unroll
            for (int mt = 0; mt < 2; ++mt) pf[mt] = *(const LAS bf16x8*)(pl + (16 * mt + c) * PL_PSTR + 128 * grp + 32 * s + 8 * g);
#pragma unroll
            for (int n = 0; n < 4; ++n)
#pragma unroll
                for (int mt = 0; mt < 2; ++mt) acc[mt][n] = __builtin_amdgcn_mfma_f32_16x16x32_bf16(wf[s][n], pf[mt], acc[mt][n], 0, 0, 0);
        }
#pragma unroll
        for (int np = 0; np < 2; ++np)
#pragma unroll
            for (int mt = 0; mt < 2; ++mt) { v2u x_, y_;
                x_.x = pk2(acc[mt][2 * np][0] * psc[2 * np].x, acc[mt][2 * np][1] * psc[2 * np].y); x_.y = pk2(acc[mt][2 * np][2] * psc[2 * np].z, acc[mt][2 * np][3] * psc[2 * np].w);
                y_.x = pk2(acc[mt][2 * np + 1][0] * psc[2 * np + 1].x, acc[mt][2 * np + 1][1] * psc[2 * np + 1].y); y_.y = pk2(acc[mt][2 * np + 1][2] * psc[2 * np + 1].z, acc[mt][2 * np + 1][3] * psc[2 * np + 1].w);
                const v2u r0 = __builtin_amdgcn_permlane16_swap(x_.x, y_.x, false, false), r1 = __builtin_amdgcn_permlane16_swap(x_.y, y_.y, false, false);
                const int d0 = 128 * grp + 16 * (4 * nh + 2 * np + (g & 1)) + 4 * (g & ~1);
                *(v4u*)(Mx + (size_t)(tok0 + 16 * mt + c) * 512 + d0) = (v4u){r0.x, r1.x, r0.y, r1.y}; }
        buf ^= 1;
    }
    asm volatile("s_waitcnt vmcnt(0) lgkmcnt(0)" ::: "memory"); __builtin_amdgcn_s_barrier(); asm volatile("" ::: "memory");
}
#undef POOL_DISPATCH

__device__ __forceinline__ void p5_rows(const Ptrs& P, LAS unsigned char* lds, int tid, int wave, int lane, int G, bool dispatch) {
    unsigned char* ws = P.ws;
    const bf16* X1 = (const bf16*)(ws + WS_X1B); unsigned char* H2 = ws + WS_H28;
    const bf16* Whi = (const bf16*)(ws + WS_WRHI); const bf16* Wlo = (const bf16*)(ws + WS_WRLO);
    int* ltok = (int*)(ws + WS_LTOK); const float* ssp = (const float*)(ws + WS_SSP); float* topw = (float*)(ws + WS_TOPW);
    unsigned* gcnt = (unsigned*)(ws + WS_CTL) + CW_GCNT;
    LAS int* tab = (LAS int*)(lds + TAB_OFF);
    LAS float* lg = (LAS float*)(lds + wave * 2048);
    const int r = lane & 15, g = lane >> 4;
    for (int g0 = blockIdx.x * NWAVES; g0 < NTOK / 16; g0 += G * NWAVES) {
        if (tid < 64) tab[T_LCNT + tid] = 0;
        for (int i = tid; i < 2 * 32 * 128; i += NWAVES * 64) { const int m = i >> 12, e = (i >> 7) & 31, ch = i & 127;
            const v4u w = *(const v4u*)((m ? Wlo : Whi) + (size_t)e * D + 8 * ch);
            *(LAS v4u*)(lds + m * 65536 + e * 2048 + ((ch ^ (e & 15)) << 4)) = w; }
        __syncthreads();
        const int row = (g0 + wave) * 16 + r;
        const bf16* xp = X1 + (size_t)row * D + 8 * g;
        f32x4 acc0 = {0.f, 0.f, 0.f, 0.f}, acc1 = {0.f, 0.f, 0.f, 0.f};
        float rstd;
        { const f32x4* sp = (const f32x4*)(ssp + (size_t)row * 16); const f32x4 s0 = sp[0], s1 = sp[1], s2 = sp[2], s3 = sp[3];
          const float ss = (((s0.x + s0.y) + (s0.z + s0.w)) + ((s1.x + s1.y) + (s1.z + s1.w))) + (((s2.x + s2.y) + (s2.z + s2.w)) + ((s3.x + s3.y) + (s3.z + s3.w)));
          rstd = 1.0f / sqrtf(ss * (1.f / D) + RMS_EPS); }
        const LAS unsigned char* wb0 = lds + r * 2048, * wb1 = lds + (16 + r) * 2048;
        v2u hprev = {0u, 0u};
#pragma unroll 4
        for (int s = 0; s < 32; ++s) {
            const v4u xw = *(const v4u*)(xp + 32 * s);
            const f32x4 v0 = (f32x4){bflo(xw.x), bfhi(xw.x), bflo(xw.y), bfhi(xw.y)} * rstd, v1 = (f32x4){bflo(xw.z), bfhi(xw.z), bflo(xw.w), bfhi(xw.w)} * rstd;
            const f32x4 ga = *(const f32x4*)(P.norm_ffn_g + 32 * s + 8 * g), gb = *(const f32x4*)(P.norm_ffn_g + 32 * s + 8 * g + 4);
            const float p[8] = {v0.x * ga.x, v0.y * ga.y, v0.z * ga.z, v0.w * ga.w, v1.x * gb.x, v1.y * gb.y, v1.z * gb.z, v1.w * gb.w};
            unsigned hi[4], lo[4];
#pragma unroll
            for (int j = 0; j < 4; ++j) { const unsigned ha = f2bf(p[2 * j]), hb = f2bf(p[2 * j + 1]); hi[j] = ha | (hb << 16);
                lo[j] = pk2(p[2 * j] - __builtin_bit_cast(float, ha << 16), p[2 * j + 1] - __builtin_bit_cast(float, hb << 16)); }
            const v4u hv = {hi[0], hi[1], hi[2], hi[3]};
            { v2u h8; h8.x = pk4_fp8(p[0], p[1], p[2], p[3]); h8.y = pk4_fp8(p[4], p[5], p[6], p[7]);
              if (s & 1) { const v2u r0 = __builtin_amdgcn_permlane16_swap(hprev.x, h8.x, false, false), r1 = __builtin_amdgcn_permlane16_swap(hprev.y, h8.y, false, false);
                  *(v4u*)(H2 + (size_t)row * D + 32 * (s - 1 + (g & 1)) + 8 * (g & ~1)) = (v4u){r0.x, r1.x, r0.y, r1.y}; }
              else hprev = h8; }
            const bf16x8 ah = __builtin_bit_cast(bf16x8, hv), al = __builtin_bit_cast(bf16x8, (v4u){lo[0], lo[1], lo[2], lo[3]});
            const int co = (((4 * s + g) ^ r) << 4);
            const bf16x8 wh0 = *(const LAS bf16x8*)(wb0 + co), wh1 = *(const LAS bf16x8*)(wb1 + co);
            const bf16x8 wl0 = *(const LAS bf16x8*)(wb0 + 65536 + co), wl1 = *(const LAS bf16x8*)(wb1 + 65536 + co);
            acc0 = __builtin_amdgcn_mfma_f32_16x16x32_bf16(wh0, ah, acc0, 0, 0, 0); acc0 = __builtin_amdgcn_mfma_f32_16x16x32_bf16(wh0, al, acc0, 0, 0, 0); acc0 = __builtin_amdgcn_mfma_f32_16x16x32_bf16(wl0, ah, acc0, 0, 0, 0);
            acc1 = __builtin_amdgcn_mfma_f32_16x16x32_bf16(wh1, ah, acc1, 0, 0, 0); acc1 = __builtin_amdgcn_mfma_f32_16x16x32_bf16(wh1, al, acc1, 0, 0, 0); acc1 = __builtin_amdgcn_mfma_f32_16x16x32_bf16(wl1, ah, acc1, 0, 0, 0);
        }
        __syncthreads();
        { const f32x4 b0 = *(const f32x4*)(P.b_router + 4 * g), b1 = *(const f32x4*)(P.b_router + 16 + 4 * g);
          *(LAS f32x4*)(lg + r * 32 + 4 * g) = acc0 + b0; *(LAS f32x4*)(lg + r * 32 + 16 + 4 * g) = acc1 + b1; }
        LDS_WAIT(); asm volatile("" ::: "memory");
        int idx[4] = {0, 0, 0, 0}; float wgt[4] = {0.f, 0.f, 0.f, 0.f}; int rank[4] = {0, 0, 0, 0};
        const int half = row >= HALF_TOK ? 1 : 0;
        if (lane < 16 && dispatch) {
            float v[32];
#pragma unroll
            for (int q = 0; q < 8; ++q) { const f32x4 t = *(const LAS f32x4*)(lg + lane * 32 + 4 * q); v[4 * q] = t.x; v[4 * q + 1] = t.y; v[4 * q + 2] = t.z; v[4 * q + 3] = t.w; }
            float val[4];
#pragma unroll
            for (int k = 0; k < 4; ++k) { float best = v[0]; int bi = 0;
#pragma unroll
                for (int e = 1; e < 32; ++e) { const bool gt = v[e] > best; best = gt ? v[e] : best; bi = gt ? e : bi; }
                val[k] = best; idx[k] = bi;
#pragma unroll
                for (int e = 0; e < 32; ++e) v[e] = (e == bi) ? -__builtin_inff() : v[e]; }
            float den = 0.f;
#pragma unroll
            for (int k = 0; k < 4; ++k) { wgt[k] = __builtin_amdgcn_exp2f((val[k] - val[0]) * 1.4426950408889634f); den += wgt[k]; }
            const float id = 1.0f / den;
#pragma unroll
            for (int k = 0; k < 4; ++k) { wgt[k] *= id; rank[k] = __hip_atomic_fetch_add(tab + T_LCNT + half * 32 + idx[k], 1, __ATOMIC_RELAXED, __HIP_MEMORY_SCOPE_WORKGROUP); }
        }
        __syncthreads();
        if (tid < 64 && dispatch) { const int cn = tab[T_LCNT + tid]; int base = 0; if (cn > 0) base = (int)__hip_atomic_fetch_add(gcnt + tid * 16, (unsigned)cn, __ATOMIC_RELAXED, __HIP_MEMORY_SCOPE_AGENT); tab[T_LBASE + tid] = base; }
        __syncthreads();
        if (lane < 16 && dispatch) {
#pragma unroll
            for (int k = 0; k < 4; ++k) { const int pos = tab[T_LBASE + half * 32 + idx[k]] + rank[k];
                if (pos < LCAP) ltok[(size_t)(half * NE + idx[k]) * LCAP + pos] = row * 4 + k;
                topw[(size_t)row * 4 + k] = wgt[k]; }
        }
        __syncthreads();
    }
}

__device__ __forceinline__ void build_tables(const Ptrs& P, LAS unsigned char* lds, int tid, int mode) {
    const unsigned* gcnt = (const unsigned*)(P.ws + WS_CTL) + CW_GCNT;
    LAS int* tab = (LAS int*)(lds + TAB_OFF); LAS unsigned* rbmap = (LAS unsigned*)(lds + RBMAP_OFF);
    __syncthreads();
    if (tid < 64) { int v = (int)__hip_atomic_load(gcnt + tid * 16, __ATOMIC_RELAXED, __HIP_MEMORY_SCOPE_AGENT); v = v < LCAP ? v : LCAP; tab[(tid < 32 ? T_CNT0 : T_CNT1 - 32) + tid] = v; }
    __syncthreads();
    if (tid < 32) {
        int ps = 0, rs = 0;
        for (int e = 0; e < tid; ++e) { const int c0 = tab[T_CNT0 + e], c1 = tab[T_CNT1 + e]; ps += (c0 + c1 + 255) >> 8;
            rs += mode == 0 ? (c0 + c1 + 255) >> 8 : (mode == 1 ? (c0 + 255) >> 8 : (c1 + 255) >> 8); }
        const int c0 = tab[T_CNT0 + tid], c1 = tab[T_CNT1 + tid];
        const int mine = mode == 0 ? (c0 + c1 + 255) >> 8 : (mode == 1 ? (c0 + 255) >> 8 : (c1 + 255) >> 8);
        tab[T_PSTART + tid] = ps * 256;
        for (int rb = 0; rb < mine; ++rb) rbmap[rs + rb] = ((unsigned)tid << 16) | (unsigned)rb;
        if (tid == 31) tab[T_NRBTOT] = rs + mine;
    }
    __syncthreads();
}

constexpr int NCONV_GU = NE * 2 * 256, NCONV = NCONV_GU + NE * 256;
__device__ __forceinline__ void conv_item(const Ptrs& P, int it, LAS float* scr, int lane) {
    const bool gu = it < NCONV_GU; const int i2 = gu ? it : it - NCONV_GU;
    const int e = gu ? i2 >> 9 : i2 >> 8, sel = (i2 >> 8) & 1, q = i2 & 255, kb = q >> 5, n0 = 32 * (q & 31);
    const float* W = (gu ? (sel ? P.w_up : P.w_gate) : P.w_down) + (size_t)e * D * DFF;
    unsigned char* WT = gu ? P.ws + WS_WGU8 + (size_t)e * 2048 * 1024 : P.ws + WS_WD8 + (size_t)e * 1024 * 1024;
    const int drow = gu ? 256 * (n0 >> 7) + 128 * sel + (n0 & 127) : n0;
    transpose_item8w(W, DFF, WT, 128 * kb, n0, drow, 64.0f, scr, lane);
}
__device__ __forceinline__ unsigned conv_grab_v(unsigned* ctr, int lane) { unsigned v = 0; if (lane == 0) v = __hip_atomic_fetch_add(ctr, 1u, __ATOMIC_RELAXED, __HIP_MEMORY_SCOPE_AGENT); return v; }
template <class R>
__device__ __forceinline__ void conv_run(const Ptrs& P, LAS unsigned char* lds, int wave, int lane, int G, R&& released) {
    LAS float* scr = (LAS float*)(lds + wave * 17408);
    unsigned* ctr0 = (unsigned*)(P.ws + WS_CTL) + CW_CONV;
    const int NGW = G * NWAVES, jmax = 8 * ((NCONV + NGW - 1) / NGW);
    const int own = blockIdx.x, partner = (own + G / 2) % G;
    for (int side = 0; side < 2; ++side) {
        const int blk = side ? partner : own; unsigned* ctr = ctr0 + 16 * blk;
        for (;;) {
            if (released()) return;
            const int j = __builtin_amdgcn_readfirstlane((int)conv_grab_v(ctr, lane));
            if (j >= jmax) break;
            const int it = (j >> 3) * NGW + blk * 8 + (j & 7);
            if (it < NCONV) conv_item(P, it, scr, lane);
        }
    }
}

__device__ __forceinline__ void p9_rows(const Ptrs& P, int wave, int lane, int G) {
    const unsigned char* Y = P.ws + WS_Y; const float* topw = (const float*)(P.ws + WS_TOPW); const bf16* X1 = (const bf16*)(P.ws + WS_X1B);
    f32x4 gf[4];
#pragma unroll
    for (int t = 0; t < 4; ++t) gf[t] = *(const f32x4*)(P.norm_final_g + 256 * t + 4 * lane);
    v2u xw[4]; unsigned yv[4][4]; f32x4 w4;
    const unsigned lo4 = 4u * (unsigned)lane, lo8 = 8u * (unsigned)lane;
#define P9_LOAD(XW, YV, W4, R0) do { const int row = (R0); \
            _Pragma("unroll") for (int t = 0; t < 4; ++t) XW[t] = *(const v2u*)((const unsigned char*)(X1 + (size_t)row * D + 256 * t) + lo8); \
            W4 = *(const f32x4*)(topw + (size_t)row * 4); \
            _Pragma("unroll") for (int k = 0; k < 4; ++k) _Pragma("unroll") for (int t = 0; t < 4; ++t) YV[k][t] = *(const unsigned*)(Y + ((size_t)row * 4 + k) * D + 256 * t + lo4); } while (0)
    const int r_lo = (int)(((long)NTOK * blockIdx.x) / G), r_hi = (int)(((long)NTOK * (blockIdx.x + 1)) / G);
    { const int r00 = r_lo + wave; P9_LOAD(xw, yv, w4, (r00 < r_hi ? r00 : r_lo)); }
    for (int row = r_lo + wave; row < r_hi; row += NWAVES) {
        v2u nxw[4]; unsigned nyv[4][4]; f32x4 nw4;
        { const int rn = (row + NWAVES < r_hi) ? row + NWAVES : row; P9_LOAD(nxw, nyv, nw4, rn); }
        {
            f32x4 v[4];
#pragma unroll
            for (int t = 0; t < 4; ++t) { const v2u x_ = xw[t]; v[t] = (f32x4){bflo(x_.x), bfhi(x_.x), bflo(x_.y), bfhi(x_.y)}; }
            const float wk[4] = {w4.x, w4.y, w4.z, w4.w};
#pragma unroll
            for (int k = 0; k < 4; ++k) { const float wq = wk[k] * 0.125f;
#pragma unroll
                for (int t = 0; t < 4; ++t) { const f32x2 a0 = __builtin_amdgcn_cvt_pk_f32_fp8((int)yv[k][t], false), a1 = __builtin_amdgcn_cvt_pk_f32_fp8((int)yv[k][t], true);
                    v[t].x += wq * a0.x; v[t].y += wq * a0.y; v[t].z += wq * a1.x; v[t].w += wq * a1.y; } }
            float s = 0.f;
#pragma unroll
            for (int t = 0; t < 4; ++t) s += (v[t].x * v[t].x + v[t].y * v[t].y) + (v[t].z * v[t].z + v[t].w * v[t].w);
            const float rstd = 1.0f / sqrtf(wave_sum(s) * (1.f / D) + RMS_EPS);
            float* xr = P.out + (size_t)row * D;
#pragma unroll
            for (int t = 0; t < 4; ++t) *(f32x4*)((unsigned char*)(xr + 256 * t) + 4u * lo4) = v[t] * rstd * gf[t]; }
        w4 = nw4;
#pragma unroll
        for (int t = 0; t < 4; ++t) { xw[t] = nxw[t];
#pragma unroll
            for (int k = 0; k < 4; ++k) yv[k][t] = nyv[k][t]; }
    }
#undef P9_LOAD
}

struct Args { Ptrs p; int ph_lo, ph_hi; };
__global__ void __launch_bounds__(NWAVES * 64, 2) mk_fwd(Args args) {
    extern __shared__ __attribute__((aligned(16))) unsigned char lds_raw[];
    LAS unsigned char* lds = (LAS unsigned char*)lds_raw;
    const Ptrs& P = args.p;
    const int G = gridDim.x;
#define IDS() int tid = threadIdx.x; asm volatile("" : "+v"(tid)); const int lane = tid & 63, wave = __builtin_amdgcn_readfirstlane(tid >> 6); (void)lane; (void)wave
    for (int u = threadIdx.x; u < (LDS_BYTES - RING_BYTES) / 4; u += NWAVES * 64) ((LAS unsigned*)(lds + RING_BYTES))[u] = 0u;
    __syncthreads();
    unsigned* ctl = (unsigned*)(P.ws + WS_CTL);
    XcdBarrier bar; bar.bar = ctl + CW_BAR; bar.x = 0; bar.st = nullptr;
    if (N_LAUNCHES == 1) bar = xcd_barrier_post(ctl + CW_BAR, (volatile LAS unsigned*)(lds + MISC_OFF) + 8);
    const int lo = args.ph_lo, hi = args.ph_hi;
#ifndef PH_MASK
#define PH_MASK 0xFFF
#endif
#ifndef REP_MASK
#define REP_MASK 0
#endif
#define REPS(k) for (int rep_ = 0; rep_ < 1 + ((REP_MASK >> (k)) & 1); ++rep_)
#define IN(k) (((PH_MASK >> (k)) & 1) && lo <= (k) && (k) < hi)
#define SEAM(k) do { if (IN(k) && IN((k) + 1)) xcd_barrier(bar); } while (0)
#define SEAM_FILL(k) do { if (IN(k) && IN((k) + 1)) { IDS(); xcd_barrier_fill(bar, [&](auto&& rel) { conv_run(P, lds, wave, lane, G, rel); }); } } while (0)
    unsigned char* ws = P.ws;
    LAS int* tab = (LAS int*)(lds + TAB_OFF); LAS unsigned* rbmap = (LAS unsigned*)(lds + RBMAP_OFF);

    if (IN(0)) REPS(0) { IDS(); p0_prologue(P, lds, wave, lane, G); __syncthreads(); } SEAM(0);
    if (IN(1)) REPS(1) {
        PolP1 S; S.A = (const char*)(ws + WS_RA); S.B = (const char*)(ws + WS_WIN); S.bias = P.b_in; S.rope = (const f32x2*)(ws + WS_ROPE); S.Q = (bf16*)(ws + WS_Q); S.K = (bf16*)(ws + WS_K); S.V = (bf16*)(ws + WS_V);
        S.U = (bf16*)(ws + WS_U); S.G = (bf16*)(ws + WS_G); S.G_ = G; S.c = blockIdx.x;
        pg8::gemm_stream(lds, S);
    } SEAM_FILL(1);
    if (IN(2)) REPS(2) {
        IDS();
        for (int rr_ = 0; rr_ < 1 + ((REP_MASK >> 17) & 1); ++rr_) attn_phase(P, lds, tid, wave, lane, G);
        for (int rr_ = 0; rr_ < 1 + ((REP_MASK >> 18) & 1); ++rr_) pool_phase(P, lds, tid, wave, lane, G);
    } SEAM_FILL(2);
    if (IN(3)) REPS(3) {
        PolP3 S; S.A0 = (const char*)(ws + WS_RA); S.B0 = (const char*)(ws + WS_WO); S.A1 = (const char*)(ws + WS_MIXED); S.B1 = (const char*)(ws + WS_WUP); S.bo = P.b_o;
        S.G = (const bf16*)(ws + WS_G); S.O = (bf16*)(ws + WS_MERGED); S.G_ = G; S.c = blockIdx.x;
        pg8::gemm_stream(lds, S);
    } SEAM_FILL(3);
    if (IN(4)) REPS(4) {
        PolP4 S; S.A = (const char*)(ws + WS_MERGED); S.B = (const char*)(ws + WS_WOUT); S.x = P.x; S.out = (bf16*)(ws + WS_X1B); S.ssp = (float*)(ws + WS_SSP); S.G_ = G; S.c = blockIdx.x;
        pg8::gemm_stream(lds, S);
    } SEAM_FILL(4);
    if (IN(5)) { IDS(); p5_rows(P, lds, tid, wave, lane, G, true); conv_run(P, lds, wave, lane, G, []() { return false; }); __syncthreads(); } SEAM(5);
    if (IN(6)) REPS(6) {
        { IDS(); build_tables(P, lds, tid, 0); }
        PolP7 S; S.H2 = (const char*)(ws + WS_H28); S.W = (const char*)(ws + WS_WGU8); S.ltok = (const int*)(ws + WS_LTOK); S.bg = P.b_gate; S.bu = P.b_up;
        S.a = ws + WS_A8; S.tab = tab; S.rbmap = rbmap; S.G_ = G; S.c = blockIdx.x;
        pg8::gemm_stream(lds, S);
    } SEAM(6);
    if (IN(7)) REPS(7) {
        { IDS(); build_tables(P, lds, tid, 0); }
        PolP8 S; S.Aa = (const char*)(ws + WS_A8); S.W = (const char*)(ws + WS_WD8); S.ltok = (const int*)(ws + WS_LTOK); S.bd = P.b_down; S.Y = ws + WS_Y; S.tab = tab; S.rbmap = rbmap; S.G_ = G; S.c = blockIdx.x;
        pg8::gemm_stream(lds, S);
    } SEAM(7);
    if (IN(8)) { IDS(); p9_rows(P, wave, lane, G); }
#undef IN
#undef SEAM
#undef IDS
}

extern "C" void kernel_launch(void* const* d_in, const int* in_sizes, int n_in, void* d_out, int out_size, void* d_ws, size_t ws_size, hipStream_t stream) {
    static int grid = 0;
    if (grid == 0) {
        if (n_in != 22 || out_size != NTOK * D || ws_size < WS_END) { fprintf(stderr, "kernel_launch: unexpected shapes (n_in %d out %d ws %zu)\n", n_in, out_size, ws_size); grid = -1; return; }
        int dev = 0, cus = 0;
        if (hipGetDevice(&dev) != hipSuccess || hipDeviceGetAttribute(&cus, hipDeviceAttributeMultiprocessorCount, dev) != hipSuccess) { grid = -1; return; }
        if (hipFuncSetAttribute((const void*)mk_fwd, hipFuncAttributeMaxDynamicSharedMemorySize, LDS_BYTES) != hipSuccess) { grid = -1; return; }
        int per_cu = 0;
        if (hipOccupancyMaxActiveBlocksPerMultiprocessor(&per_cu, (const void*)mk_fwd, NWAVES * 64, LDS_BYTES) != hipSuccess || per_cu < 1) fprintf(stderr, "kernel_launch: occupancy query says %d\n", per_cu);
        (void)hipGetLastError();
        grid = cus > 0 ? cus : 256;
    }
    if (grid < 0) return;
    (void)hipMemsetAsync((char*)d_ws + WS_CTL, 0, CTL_ZERO_BYTES, stream);
    Args a{};
    const float** pf = (const float**)&a.p;
    a.p.x = (const float*)d_in[0]; a.p.positions = (const int*)d_in[1]; a.p.norm_mix_g = (const float*)d_in[2]; a.p.w_in = (const float*)d_in[3]; a.p.b_in = (const float*)d_in[4];
    a.p.sinks = (const float*)d_in[5]; a.p.w_o = (const float*)d_in[6]; a.p.b_o = (const float*)d_in[7]; a.p.w_pool_mix = (const float*)d_in[8]; a.p.pool_scale = (const float*)d_in[9];
    a.p.w_pool_up = (const float*)d_in[10]; a.p.w_out = (const float*)d_in[11]; a.p.norm_ffn_g = (const float*)d_in[12]; a.p.w_router = (const float*)d_in[13]; a.p.b_router = (const float*)d_in[14];
    a.p.w_gate = (const float*)d_in[15]; a.p.b_gate = (const float*)d_in[16]; a.p.w_up = (const float*)d_in[17]; a.p.b_up = (const float*)d_in[18]; a.p.w_down = (const float*)d_in[19];
    a.p.b_down = (const float*)d_in[20]; a.p.norm_final_g = (const float*)d_in[21]; a.p.out = (float*)d_out; a.p.ws = (unsigned char*)d_ws;
    (void)pf;
    if (N_LAUNCHES == 1) { a.ph_lo = 0; a.ph_hi = NPHASE; hipLaunchKernelGGL(mk_fwd, dim3(grid), dim3(NWAVES * 64), LDS_BYTES, stream, a); }
    else { for (int ph = 0; ph < NPHASE; ++ph) { a.ph_lo = ph; a.ph_hi = ph + 1; hipLaunchKernelGGL(mk_fwd, dim3(grid), dim3(NWAVES * 64), LDS_BYTES, stream, a); } }
}
```

```cpp
#include <hip/hip_runtime.h>
#include <cstdio>
#include <cstddef>

#ifndef MK_N_LAUNCHES
#define MK_N_LAUNCHES 1
#endif

#define GAS __attribute__((address_space(1)))
#define LAS __attribute__((address_space(3)))
typedef unsigned short bf16;
typedef unsigned v4u __attribute__((ext_vector_type(4)));
typedef unsigned v2u __attribute__((ext_vector_type(2)));
typedef float f32x4 __attribute__((ext_vector_type(4)));
typedef float f32x2 __attribute__((ext_vector_type(2)));
typedef short bf16x8 __attribute__((ext_vector_type(8)));
typedef int v8i __attribute__((ext_vector_type(8)));
typedef int v4i __attribute__((ext_vector_type(4)));
typedef GAS unsigned gu32;
#define RLX_AGENT __ATOMIC_RELAXED, __HIP_MEMORY_SCOPE_AGENT
#define LDS_WAIT() asm volatile("s_waitcnt lgkmcnt(0)" ::: "memory")
#define VM_WAIT() asm volatile("s_waitcnt vmcnt(0)" ::: "memory")

constexpr int NB = 8, SEQ = 4096, D = 1024, NTOK = NB * SEQ;
constexpr int HD = 64, NQH = 16, NKVH = 2;
constexpr int POOLW = 512;
constexpr int INW = 3840;
constexpr int NE = 32, DFF = 1024;
constexpr int HALF_TOK = NTOK / 2;
constexpr int LCAP = 16384;
constexpr float RMS_EPS = 1e-5f;
constexpr int NWAVES = 8;
constexpr int NPHASE = 9;
constexpr int N_LAUNCHES = MK_N_LAUNCHES;

constexpr size_t MiB = 1u << 20;
constexpr size_t WS_CTL = 0, CTL_ZERO_BYTES = 128 * 1024;
constexpr size_t WS_ROPE = 1 * MiB;
constexpr size_t WS_TOPW = 9 * MiB;
constexpr size_t WS_LTOK = 10 * MiB;
constexpr size_t WS_SSP = 14 * MiB;
constexpr size_t WS_WRHI = 18 * MiB;
constexpr size_t WS_WRLO = 18 * MiB + 65536;
constexpr size_t WS_WMIX = 18 * MiB + 2 * 65536;
constexpr size_t WS_WIN = 19 * MiB;
constexpr size_t WS_WO = 27 * MiB;
constexpr size_t WS_WUP = 29 * MiB;
constexpr size_t WS_WOUT = 30 * MiB;
constexpr size_t WS_WD8 = 32 * MiB;
constexpr size_t WS_RA = 64 * MiB;
constexpr size_t WS_RB = 128 * MiB;
constexpr size_t WS_Q = WS_RB, WS_K = WS_Q + 64 * MiB, WS_V = WS_K + 8 * MiB, WS_U = WS_V + 8 * MiB, WS_G = WS_U + 32 * MiB;
constexpr size_t WS_MIXED = 368 * MiB, WS_MERGED = 400 * MiB;
constexpr size_t WS_END = 528 * MiB;
constexpr size_t WS_A8 = 64 * MiB;
constexpr size_t WS_Y = 201 * MiB;
constexpr size_t WS_X1B = 329 * MiB;
constexpr size_t WS_H28 = 208 * MiB;
constexpr size_t WS_WGU8 = 464 * MiB;
static_assert(WS_Y + 128 * MiB <= WS_X1B && WS_A8 + 137 * MiB <= WS_Y && WS_X1B + 64 * MiB <= WS_MERGED && WS_MERGED + 64 * MiB <= WS_WGU8 && WS_WGU8 + 64 * MiB <= WS_END, "ws map");
static_assert(WS_G + 128 * MiB <= WS_MIXED, "ws map");
constexpr int CW_TMO = 0;
constexpr int CW_BAR = 4096;
constexpr int CW_GCNT = 8192;
constexpr int CW_CONV = 12288;

constexpr int RING_BYTES = 131072;
constexpr int TAB_OFF = RING_BYTES;
constexpr int T_CNT0 = 0, T_CNT1 = 32, T_PSTART = 64, T_NRBTOT = 100, T_LCNT = 128, T_LBASE = 192;
constexpr int RBMAP_OFF = RING_BYTES + 1024;
constexpr int MISC_OFF = RING_BYTES + 8192;
constexpr int P5_GAIN_OFF = RING_BYTES + 4096;
constexpr int LDS_BYTES = 147456;

__device__ __forceinline__ unsigned f2bf(float f) { unsigned u = __builtin_bit_cast(unsigned, f); return (u + 0x7fffu + ((u >> 16) & 1u)) >> 16; }
__device__ __forceinline__ unsigned pk2(float lo, float hi) { unsigned r; asm("v_cvt_pk_bf16_f32 %0, %1, %2" : "=v"(r) : "v"(lo), "v"(hi)); return r; }
__device__ __forceinline__ float bflo(unsigned w) { return __builtin_bit_cast(float, w << 16); }
__device__ __forceinline__ float bfhi(unsigned w) { return __builtin_bit_cast(float, w & 0xffff0000u); }
__device__ __forceinline__ float sigmoidf_(float x) { return __builtin_amdgcn_rcpf(1.0f + __builtin_amdgcn_exp2f(-1.4426950408889634f * x)); }

#define XB_TMO      128
#define XB_XCNT(j)  (256  + 64 * (j))
#define XB_XSUB(j)  (1280 + 64 * (j))
#define XB_XGEN(j)  (2304 + 64 * (j))
#define XB_TOP      3328
#define XB_TOPGEN   3392
#define XCD_BAR_WORDS 3456
#define XB_SPIN_CAP (1u << 18)
__device__ __forceinline__ unsigned xb_ld(unsigned* p)              { return __hip_atomic_load(p, __ATOMIC_RELAXED, __HIP_MEMORY_SCOPE_AGENT); }
__device__ __forceinline__ unsigned xb_add(unsigned* p, unsigned v) { return __hip_atomic_fetch_add(p, v, __ATOMIC_RELAXED, __HIP_MEMORY_SCOPE_AGENT); }
__device__ __forceinline__ unsigned xb_xcc_id() { return (unsigned)__builtin_amdgcn_s_getreg((3 << 11) | 20) & 0xFu; }
#define XB_SPIN(cond, bar) do { unsigned _sp = 0; while (cond) { __builtin_amdgcn_s_sleep(1); \
    if ((++_sp & 255u) == 0u) { if (xb_ld(&(bar)[XB_TMO])) break; if (_sp > XB_SPIN_CAP) { atomicAdd(&(bar)[XB_TMO], 1u); break; } } } } while (0)
struct XcdBarrier { unsigned* bar; unsigned x; volatile LAS unsigned* st; };
__device__ __forceinline__ XcdBarrier xcd_barrier_post(unsigned* bar, volatile LAS unsigned* st) {
    XcdBarrier b; b.bar = bar; b.x = xb_xcc_id(); b.st = st;
    if (threadIdx.x == 0) (void)xb_add(&bar[XB_XCNT(b.x)], 1u);
    return b;
}
__device__ __forceinline__ void xcd_barrier_complete(unsigned* bar, unsigned x, unsigned& nloc, unsigned& nx) {
    const unsigned G = gridDim.x * gridDim.y * gridDim.z;
    unsigned sum, cnt, mine, sp = 0u;
    for (;;) {
        sum = 0u; cnt = 0u; mine = 0u;
#pragma unroll
        for (unsigned j = 0; j < 16; ++j) { const unsigned c = xb_ld(&bar[XB_XCNT(j)]); sum += c; cnt += (c > 0u) ? 1u : 0u; mine = (j == x) ? c : mine; }
        if (sum == G) break;
        __builtin_amdgcn_s_sleep(1);
        if ((++sp & 255u) == 0u) { if (xb_ld(&bar[XB_TMO])) break; if (sp > XB_SPIN_CAP) { atomicAdd(&bar[XB_TMO], 1u); break; } }
    }
    nloc = mine > 0u ? mine : 1u; nx = cnt > 0u ? cnt : 1u;
}
__device__ __forceinline__ void xcd_barrier(const XcdBarrier& b) {
    asm volatile("s_waitcnt vmcnt(0)" ::: "memory");
    __syncthreads();
    if (threadIdx.x == 0) {
        unsigned* bar = b.bar;
        __builtin_amdgcn_s_waitcnt(0);
        unsigned nloc = b.st[0], nx = b.st[1];
        if (nloc == 0u) { xcd_barrier_complete(bar, b.x, nloc, nx); b.st[0] = nloc; b.st[1] = nx; }
        const unsigned old = xb_add(&bar[XB_XSUB(b.x)], 1u);
        const unsigned gen = old / nloc;
        if (old + 1u == (gen + 1u) * nloc) {
            __builtin_amdgcn_fence(__ATOMIC_RELEASE, "agent");
            asm volatile("s_waitcnt vmcnt(0)" ::: "memory");
            const unsigned og = xb_add(&bar[XB_TOP], 1u);
            const unsigned tg = og / nx;
            if (og + 1u == (tg + 1u) * nx) xb_add(&bar[XB_TOPGEN], 1u);
            else XB_SPIN(xb_ld(&bar[XB_TOPGEN]) == tg, bar);
            __builtin_amdgcn_fence(__ATOMIC_ACQUIRE, "agent");
            xb_add(&bar[XB_XGEN(b.x)], 1u);
            asm volatile("s_waitcnt vmcnt(0)" ::: "memory");
        } else {
            XB_SPIN(xb_ld(&bar[XB_XGEN(b.x)]) == gen, bar);
            __builtin_amdgcn_fence(__ATOMIC_ACQUIRE, "agent");
            asm volatile("s_waitcnt vmcnt(0)" ::: "memory");
        }
    }
    __syncthreads();
}

template <class F>
__device__ __forceinline__ void xcd_barrier_fill(const XcdBarrier& b, F&& fill) {
    asm volatile("s_waitcnt vmcnt(0)" ::: "memory");
    __syncthreads();
    if (threadIdx.x == 0) {
        unsigned* bar = b.bar;
        __builtin_amdgcn_s_waitcnt(0);
        unsigned nloc = b.st[0], nx = b.st[1];
        if (nloc == 0u) { xcd_barrier_complete(bar, b.x, nloc, nx); b.st[0] = nloc; b.st[1] = nx; }
        const unsigned old = xb_add(&bar[XB_XSUB(b.x)], 1u);
        const unsigned gen = old / nloc;
        b.st[2] = gen; b.st[3] = (old + 1u == (gen + 1u) * nloc) ? 1u : 0u;
    }
    __syncthreads();
    const unsigned gen = b.st[2], leader = b.st[3];
    if (!leader) { unsigned* xg = &b.bar[XB_XGEN(b.x)]; fill([&]() { return xb_ld(xg) != gen; }); }
    asm volatile("s_waitcnt vmcnt(0)" ::: "memory");
    __syncthreads();
    if (threadIdx.x == 0) {
        unsigned* bar = b.bar;
        if (leader) {
            const unsigned nx = b.st[1];
            __builtin_amdgcn_fence(__ATOMIC_RELEASE, "agent");
            asm volatile("s_waitcnt vmcnt(0)" ::: "memory");
            const unsigned og = xb_add(&bar[XB_TOP], 1u);
            const unsigned tg = og / nx;
            if (og + 1u == (tg + 1u) * nx) xb_add(&bar[XB_TOPGEN], 1u);
            else XB_SPIN(xb_ld(&bar[XB_TOPGEN]) == tg, bar);
            __builtin_amdgcn_fence(__ATOMIC_ACQUIRE, "agent");
            xb_add(&bar[XB_XGEN(b.x)], 1u);
            asm volatile("s_waitcnt vmcnt(0)" ::: "memory");
        } else {
            XB_SPIN(xb_ld(&bar[XB_XGEN(b.x)]) == gen, bar);
            __builtin_amdgcn_fence(__ATOMIC_ACQUIRE, "agent");
            asm volatile("s_waitcnt vmcnt(0)" ::: "memory");
        }
    }
    __syncthreads();
}

namespace pg8 {
constexpr int BM = 256, BK = 64, HALF = 128, HTB = HALF * BK * 2, NXCD = 8, WGM = 3;
__device__ __forceinline__ int lds_byte(int r, int c) { const int st = (r >> 4) * 2 + (c >> 5), rr = r & 15, cc = c & 31, ob = rr * 64 + cc * 2; return st * 1024 + (ob ^ (((ob >> 9) & 1) << 5)); }
__device__ __forceinline__ void stage_rc(int b, int& R, int& C) { const int st = b / 1024, sb = b % 1024, swz = sb ^ (((sb >> 9) & 1) << 5); R = (st >> 1) * 16 + swz / 64; C = (st & 1) * 32 + (swz % 64) / 2; }
__device__ __forceinline__ int perm32(int rho) { const int n = rho >> 4, i = rho & 15; return 8 * (i >> 2) + 4 * n + (i & 3); }

struct Unit { const char* A; const char* B; int nt; int ldb; int kind; int pm; int pn; int e; int r0; int aux; };
__device__ __forceinline__ bool tile_order(int nM, int nN, int G, int c, int i, int& pm, int& pn) {
    const int nwg = nM * nN; const long L = (long)i * G + c; if (L >= nwg) return false;
    int wgid = (int)L; { const int q = nwg / NXCD, r = nwg % NXCD, xcd = wgid % NXCD, off = wgid / NXCD; wgid = (xcd < r ? xcd * (q + 1) : r * (q + 1) + (xcd - r) * q) + off; }
    const int nig = WGM * nN, gid = wgid / nig, fm = gid * WGM, gsz = (nM - fm) < WGM ? (nM - fm) : WGM;
    pm = fm + ((wgid % nig) % gsz); pn = (wgid % nig) / gsz; return true;
}
__device__ __forceinline__ unsigned cvt_pk_bf16(float lo, float hi) { unsigned r; asm volatile("v_cvt_pk_bf16_f32 %0, %1, %2" : "=v"(r) : "v"(lo), "v"(hi)); return r; }

template <class P>
__device__ __forceinline__ void gemm_stream(LAS unsigned char* lds, const P& S) {
    int tid = threadIdx.x; asm volatile("" : "+v"(tid));
    const int wid = __builtin_amdgcn_readfirstlane(tid >> 6), lane = tid & 63, wr = wid >> 2, wc = wid & 3, fr = lane & 15, fq = lane >> 4;
    int Rb[2], C2[2];
#pragma unroll
    for (int i = 0; i < 2; ++i) { int R, C; stage_rc(tid * 16 + i * 8192, R, C); Rb[i] = P::PERM ? ((R & ~31) + perm32(R & 31)) : R; C2[i] = C * 2; }
    const size_t kstep = (size_t)(BK * 2);
    const unsigned ldsw = (unsigned)wid * 1024u;
    const int aoff = lds_byte(wr * 64 + fr, fq * 8), boff = lds_byte(wc * 32 + fr, fq * 8);
#define PG8_SA(b, h) (((b) * 2 + (h)) * HTB)
#define PG8_SB(b, h) ((4 + (b) * 2 + (h)) * HTB)
#define PG8_STAGE2(bufoff, gbase, v0, v1) do { \
        __builtin_amdgcn_global_load_lds((const unsigned*)((const char*)(gbase) + (v0)), (LAS unsigned*)(lds + (bufoff) + ldsw), 16, 0, 0); \
        __builtin_amdgcn_global_load_lds((const unsigned*)((const char*)(gbase) + (v1)), (LAS unsigned*)(lds + (bufoff) + ldsw + 8192), 16, 0, 0); } while (0)
#define PG8_LDA(dst, b, h) do { _Pragma("unroll") for (int m = 0; m < 4; ++m) { const v4i lo_ = *(const LAS v4i*)(lds + PG8_SA(b, h) + aoff + m * 2048), hi_ = *(const LAS v4i*)(lds + PG8_SA(b, h) + aoff + m * 2048 + 1024); dst[m] = __builtin_shufflevector(lo_, hi_, 0, 1, 2, 3, 4, 5, 6, 7); } } while (0)
#define PG8_LDB(dst, b, h) do { _Pragma("unroll") for (int n = 0; n < 2; ++n) { const v4i lo_ = *(const LAS v4i*)(lds + PG8_SB(b, h) + boff + n * 2048), hi_ = *(const LAS v4i*)(lds + PG8_SB(b, h) + boff + n * 2048 + 1024); dst[n] = __builtin_shufflevector(lo_, hi_, 0, 1, 2, 3, 4, 5, 6, 7); } } while (0)
#define PG8_LO(x) __builtin_bit_cast(bf16x8, __builtin_shufflevector((x), (x), 0, 1, 2, 3))
#define PG8_HI(x) __builtin_bit_cast(bf16x8, __builtin_shufflevector((x), (x), 4, 5, 6, 7))
#define PG8_MMA(ai, bj, At, Bt) do { __builtin_amdgcn_s_setprio(1); \
        if constexpr (P::FP8) { _Pragma("unroll") for (int m = 0; m < 4; ++m) _Pragma("unroll") for (int n = 0; n < 2; ++n) \
            asm volatile("v_mfma_f32_16x16x128_f8f6f4 %0, %1, %2, %0" : "+v"(acc[ai][bj][m][n]) : "v"(Bt[n]), "v"(At[m])); } \
        else { _Pragma("unroll") for (int m = 0; m < 4; ++m) _Pragma("unroll") for (int n = 0; n < 2; ++n) { \
            acc[ai][bj][m][n] = __builtin_amdgcn_mfma_f32_16x16x32_bf16(PG8_LO(Bt[n]), PG8_LO(At[m]), acc[ai][bj][m][n], 0, 0, 0); \
            acc[ai][bj][m][n] = __builtin_amdgcn_mfma_f32_16x16x32_bf16(PG8_HI(Bt[n]), PG8_HI(At[m]), acc[ai][bj][m][n], 0, 0, 0); } } \
        __builtin_amdgcn_s_setprio(0); } while (0)
#define PG8_WAIT_V(n) asm volatile("s_waitcnt vmcnt(" #n ")" ::: "memory")
#define PG8_WAIT_L(n) asm volatile("s_waitcnt lgkmcnt(" #n ")" ::: "memory")
#define PG8_BAR __builtin_amdgcn_s_barrier()
#define PG8_SCHED __builtin_amdgcn_sched_barrier(0)
    Unit cur, nxt; int ui = 0;
    if (!S.next(0, cur)) return;
    f32x4 acc[2][2][4][2];
#pragma unroll
    for (int a = 0; a < 2; ++a)
#pragma unroll
        for (int b = 0; b < 2; ++b)
#pragma unroll
            for (int m = 0; m < 4; ++m)
#pragma unroll
                for (int n = 0; n < 2; ++n) acc[a][b][m][n] = (f32x4){0.f, 0.f, 0.f, 0.f};
    v8i At[4], B0[2], B1[2];
    unsigned vA[2][2], vB[2];
    { int idx0[2][2] = {{0, 0}, {0, 0}}; S.lane_issue(cur, tid, idx0); S.lane_finish(cur, tid, idx0, vA); }
    vB[0] = (unsigned)(Rb[0] * cur.ldb + C2[0]); vB[1] = (unsigned)(Rb[1] * cur.ldb + C2[1]);
    const char* cA = cur.A; const char* cB = cur.B; size_t hB = (size_t)HALF * cur.ldb;
    PG8_STAGE2(PG8_SB(0, 0), cB, vB[0], vB[1]); PG8_STAGE2(PG8_SB(0, 1), cB + hB, vB[0], vB[1]); PG8_STAGE2(PG8_SA(0, 0), cA, vA[0][0], vA[0][1]); PG8_STAGE2(PG8_SA(0, 1), cA, vA[1][0], vA[1][1]);
    if (wr == 1) PG8_BAR;
    PG8_WAIT_V(2); PG8_BAR;
    PG8_STAGE2(PG8_SB(1, 0), cB + kstep, vB[0], vB[1]); PG8_STAGE2(PG8_SA(1, 0), cA + kstep, vA[0][0], vA[0][1]); PG8_STAGE2(PG8_SB(1, 1), cB + hB + kstep, vB[0], vB[1]);
    PG8_WAIT_V(6); PG8_BAR;
    for (;;) {
        bool has_next = false;
        const int nt = cur.nt;
        unsigned nvA[2][2], nvB[2];
        const char* nA = cA; const char* nB = cB; size_t nhB = hB;
#pragma unroll
        for (int h = 0; h < 2; ++h) { nvA[h][0] = vA[h][0]; nvA[h][1] = vA[h][1]; }
        nvB[0] = vB[0]; nvB[1] = vB[1];
        int nidx[2][2] = {{0, 0}, {0, 0}};
#pragma unroll 1
        for (int t = 0; t < nt; t += 2) {
            const bool last = (t == nt - 2);
            if (t == 0) { has_next = S.next(ui + 1, nxt); if (has_next) { if constexpr (!P::UNIFORM_A) S.lane_issue_asm(nxt, tid, nidx); } }
            if (last && has_next) { nA = nxt.A; nB = nxt.B; }
            const char* a1 = cA + (size_t)(t + 1) * kstep;
            const char* a2 = last ? nA : cA + (size_t)(t + 2) * kstep; const char* b2 = last ? nB : cB + (size_t)(t + 2) * kstep;
            const char* a3 = a2 + kstep; const char* b3 = b2 + kstep;
            const size_t h2 = (!P::UNIFORM_B && last) ? nhB : hB;
            const unsigned xa00 = (!P::UNIFORM_A && last) ? nvA[0][0] : vA[0][0], xa01 = (!P::UNIFORM_A && last) ? nvA[0][1] : vA[0][1], xa10 = (!P::UNIFORM_A && last) ? nvA[1][0] : vA[1][0], xa11 = (!P::UNIFORM_A && last) ? nvA[1][1] : vA[1][1];
            const unsigned xb0 = (!P::UNIFORM_B && last) ? nvB[0] : vB[0], xb1 = (!P::UNIFORM_B && last) ? nvB[1] : vB[1];
            PG8_LDB(B0, 0, 0); PG8_LDB(B1, 0, 1); PG8_SCHED; PG8_LDA(At, 0, 0); PG8_STAGE2(PG8_SA(1, 1), a1, vA[1][0], vA[1][1]);
            PG8_WAIT_V(8); PG8_WAIT_L(0); PG8_BAR; PG8_MMA(0, 0, At, B0); PG8_MMA(0, 1, At, B1); PG8_BAR; PG8_SCHED;
            PG8_LDA(At, 0, 1); PG8_STAGE2(PG8_SB(0, 0), b2, xb0, xb1); PG8_STAGE2(PG8_SB(0, 1), b2 + h2, xb0, xb1); PG8_STAGE2(PG8_SA(0, 0), a2, xa00, xa01);
            PG8_WAIT_V(8); PG8_WAIT_L(0); PG8_BAR; PG8_MMA(1, 0, At, B0); PG8_MMA(1, 1, At, B1); PG8_BAR; PG8_SCHED;
            PG8_LDB(B0, 1, 0); PG8_LDB(B1, 1, 1); PG8_SCHED; PG8_LDA(At, 1, 0); PG8_STAGE2(PG8_SA(0, 1), a2, xa10, xa11);
            PG8_WAIT_V(8); PG8_WAIT_L(0); PG8_BAR; PG8_MMA(0, 0, At, B0); PG8_MMA(0, 1, At, B1); PG8_BAR; PG8_SCHED;
            PG8_LDA(At, 1, 1); PG8_STAGE2(PG8_SB(1, 0), b3, xb0, xb1); PG8_STAGE2(PG8_SB(1, 1), b3 + h2, xb0, xb1); PG8_STAGE2(PG8_SA(1, 0), a3, xa00, xa01);
            PG8_WAIT_V(8); PG8_WAIT_L(0); PG8_BAR; PG8_MMA(1, 0, At, B0); PG8_MMA(1, 1, At, B1); PG8_BAR; PG8_SCHED;
            if (t == 0 && has_next) {
                if constexpr (!P::UNIFORM_A) { asm volatile("" : "+v"(nidx[0][0]), "+v"(nidx[0][1]), "+v"(nidx[1][0]), "+v"(nidx[1][1])); S.lane_finish(nxt, tid, nidx, nvA); }
                if constexpr (!P::UNIFORM_B) { nvB[0] = (unsigned)(Rb[0] * nxt.ldb + C2[0]); nvB[1] = (unsigned)(Rb[1] * nxt.ldb + C2[1]); nhB = (size_t)HALF * nxt.ldb; }
            }
        }
        if (wr == 0) PG8_BAR;
        if constexpr (P::FP8) asm volatile("s_nop 15\n\ts_nop 15" ::: "memory");
        S.epilogue(acc, cur, wr, wc, fr, fq);
        if (!has_next) break;
        if (!S.keep_acc(cur)) {
#pragma unroll
            for (int a = 0; a < 2; ++a)
#pragma unroll
                for (int b = 0; b < 2; ++b)
#pragma unroll
                    for (int m = 0; m < 4; ++m)
#pragma unroll
                        for (int n = 0; n < 2; ++n) acc[a][b][m][n] = (f32x4){0.f, 0.f, 0.f, 0.f};
        }
        cur = nxt; cA = nA; cB = nB; ++ui;
        if constexpr (!P::UNIFORM_A) {
#pragma unroll
            for (int h = 0; h < 2; ++h) { vA[h][0] = nvA[h][0]; vA[h][1] = nvA[h][1]; } }
        if constexpr (!P::UNIFORM_B) { vB[0] = nvB[0]; vB[1] = nvB[1]; hB = nhB; }
        if (wr == 1) PG8_BAR;
    }
    PG8_WAIT_V(0);
    PG8_BAR;
#undef PG8_SA
#undef PG8_SB
#undef PG8_STAGE2
#undef PG8_LDA
#undef PG8_LDB
#undef PG8_MMA
#undef PG8_LO
#undef PG8_HI
#undef PG8_WAIT_V
#undef PG8_WAIT_L
#undef PG8_BAR
#undef PG8_SCHED
}
}

struct Ptrs {
    const float* x; const int* positions; const float* norm_mix_g; const float* w_in; const float* b_in; const float* sinks; const float* w_o; const float* b_o;
    const float* w_pool_mix; const float* pool_scale; const float* w_pool_up; const float* w_out; const float* norm_ffn_g; const float* w_router; const float* b_router;
    const float* w_gate; const float* b_gate; const float* w_up; const float* b_up; const float* w_down; const float* b_down; const float* norm_final_g;
    float* out; unsigned char* ws;
};

struct PolP1 {
    static constexpr bool FP8 = true, UNIFORM_A = true, UNIFORM_B = true;
    static constexpr float SC = 1.0f / 64.0f;
    static constexpr bool PERM = true;
    const char* A; const char* B; const float* bias; const f32x2* rope; bf16 *Q, *K, *V, *U, *G; int G_, c;
    __device__ __forceinline__ bool next(int i, pg8::Unit& u) const {
        int pm, pn; if (!pg8::tile_order(NTOK / 256, INW / 256, G_, c, i, pm, pn)) return false;
        u.pm = pm; u.pn = pn; u.A = A + (size_t)pm * 256 * 1024; u.B = B + (size_t)pn * 256 * 1024; u.nt = 8; u.ldb = 1024; u.kind = 0; u.e = 0; u.r0 = 0; u.aux = 0; return true; }
    __device__ __forceinline__ void lane_issue(const pg8::Unit&, int, int (&)[2][2]) const {}
    __device__ __forceinline__ void lane_issue_asm(const pg8::Unit&, int, int (&)[2][2]) const {}
    __device__ __forceinline__ void lane_finish(const pg8::Unit&, int tid_, const int (&)[2][2], unsigned (&va)[2][2]) const {
        int R[2], C2[2];
#pragma unroll
        for (int i_ = 0; i_ < 2; ++i_) { int C_; pg8::stage_rc(tid_ * 16 + i_ * 8192, R[i_], C_); C2[i_] = C_ * 2; }
#pragma unroll
        for (int h = 0; h < 2; ++h) { va[h][0] = (unsigned)((R[0] + 128 * h) * 1024 + C2[0]); va[h][1] = (unsigned)((R[1] + 128 * h) * 1024 + C2[1]); } }
    __device__ __forceinline__ bool keep_acc(const pg8::Unit&) const { return false; }
    __device__ __forceinline__ void epilogue(f32x4 (&acc)[2][2][4][2], const pg8::Unit& u, int wr, int wc, int fr, int fq) const {
        const int row0 = u.pm * 256 + wr * 64 + fr;
        if (u.pn * 256 < 1152) {
            const int jq = ((32 * wc + 8 * fq) & 63) >> 3, d0 = 4 * jq;
#pragma unroll
            for (int bj = 0; bj < 2; ++bj) {
                const int zc = u.pn * 256 + bj * 128;
                if (zc >= 1152) {
                    const int cc = wc * 32 + 8 * fq; const f32x4 b0 = *(const f32x4*)(bias + zc + cc), b1 = *(const f32x4*)(bias + zc + cc + 4);
#pragma unroll
                    for (int ai = 0; ai < 2; ++ai)
#pragma unroll
                        for (int m = 0; m < 4; ++m) { const f32x4 v0 = acc[ai][bj][m][0] * SC + b0, v1 = acc[ai][bj][m][1] * SC + b1;
                            v4u w; w.x = pg8::cvt_pk_bf16(v0[0], v0[1]); w.y = pg8::cvt_pk_bf16(v0[2], v0[3]); w.z = pg8::cvt_pk_bf16(v1[0], v1[1]); w.w = pg8::cvt_pk_bf16(v1[2], v1[3]);
                            *(v4u*)(V + (size_t)(row0 + ai * 128 + m * 16) * 128 + cc) = w; }
                } else {
                    const bool isq = zc < 1024; bf16* dst = isq ? Q : K; const int ld = isq ? 1024 : 128; const int cc = (isq ? zc : 0) + wc * 32 + 8 * fq;
                    const int hb = (zc + wc * 32 + 8 * fq) & ~63;
                    const f32x4 b0 = *(const f32x4*)(bias + hb + d0), b1 = *(const f32x4*)(bias + hb + 32 + d0);
                    const float qs = isq ? 0.125f * 1.4426950408889634f : 1.0f;
#pragma unroll
                    for (int ai = 0; ai < 2; ++ai) {
                        f32x4 ra[4], rb[4];
#pragma unroll
                        for (int m = 0; m < 4; ++m) { const f32x4* rp = (const f32x4*)(rope + (size_t)(row0 + ai * 128 + m * 16) * 32 + d0); ra[m] = rp[0]; rb[m] = rp[1]; }
#pragma unroll
                        for (int m = 0; m < 4; ++m) {
                            const f32x4 x1 = acc[ai][bj][m][0] * SC + b0, x2 = acc[ai][bj][m][1] * SC + b1;
                            const float cs[4] = {ra[m].x, ra[m].z, rb[m].x, rb[m].z}, sn[4] = {ra[m].y, ra[m].w, rb[m].y, rb[m].w};
                            float o1[4], o2[4];
#pragma unroll
                            for (int j = 0; j < 4; ++j) { o1[j] = qs * (x1[j] * cs[j] - x2[j] * sn[j]); o2[j] = qs * (x2[j] * cs[j] + x1[j] * sn[j]); }
                            v4u w; w.x = pg8::cvt_pk_bf16(o1[0], o1[1]); w.y = pg8::cvt_pk_bf16(o1[2], o1[3]); w.z = pg8::cvt_pk_bf16(o2[0], o2[1]); w.w = pg8::cvt_pk_bf16(o2[2], o2[3]);
                            v4u* dp_ = (v4u*)(dst + (size_t)(row0 + ai * 128 + m * 16) * ld + cc); if (isq) __builtin_nontemporal_store(w, dp_); else *dp_ = w; }
                    }
                }
            }
            return;
        }
        if (u.pn * 256 >= 1792) {
            const int c = ((u.pn * 256 - 1792) >> 8) * 128 + wc * 32 + 8 * fq;
            const float* bp = bias + 1792 + c;
            const f32x4 b00 = *(const f32x4*)bp, b01 = *(const f32x4*)(bp + 4), b10 = *(const f32x4*)(bp + 1024), b11 = *(const f32x4*)(bp + 1028);
            const float nl = -1.4426950408889634f;
#pragma unroll
            for (int ai = 0; ai < 2; ++ai)
#pragma unroll
                for (int m = 0; m < 4; ++m) {
                    const f32x4 z0[2] = {acc[ai][0][m][0] * SC + b00, acc[ai][0][m][1] * SC + b01}, z1[2] = {acc[ai][1][m][0] * SC + b10, acc[ai][1][m][1] * SC + b11};
                    float rho[8], g1v[8];
#pragma unroll
                    for (int h = 0; h < 2; ++h)
#pragma unroll
                        for (int j = 0; j < 4; ++j) { const float d0 = 1.0f + __builtin_amdgcn_exp2f(nl * z0[h][j]), d1 = 1.0f + __builtin_amdgcn_exp2f(nl * z1[h][j]);
                            g1v[4 * h + j] = __builtin_amdgcn_rcpf(d1); rho[4 * h + j] = d1 * __builtin_amdgcn_rcpf(d0); }
                    bf16* gp = G + (size_t)(row0 + ai * 128 + m * 16) * 2048 + c;
                    v4u w; w.x = pg8::cvt_pk_bf16(rho[0], rho[1]); w.y = pg8::cvt_pk_bf16(rho[2], rho[3]); w.z = pg8::cvt_pk_bf16(rho[4], rho[5]); w.w = pg8::cvt_pk_bf16(rho[6], rho[7]);
                    __builtin_nontemporal_store(w, (v4u*)gp);
                    w.x = pg8::cvt_pk_bf16(g1v[0], g1v[1]); w.y = pg8::cvt_pk_bf16(g1v[2], g1v[3]); w.z = pg8::cvt_pk_bf16(g1v[4], g1v[5]); w.w = pg8::cvt_pk_bf16(g1v[6], g1v[7]);
                    __builtin_nontemporal_store(w, (v4u*)(gp + 1024)); }
            return;
        }
#pragma unroll
        for (int bj = 0; bj < 2; ++bj) {
            const int zc = u.pn * 256 + bj * 128; const int cc = zc - 1280 + wc * 32 + 8 * fq;
            const float* bp = bias + zc + wc * 32 + 8 * fq; const f32x4 b0 = *(const f32x4*)bp, b1 = *(const f32x4*)(bp + 4);
#pragma unroll
            for (int ai = 0; ai < 2; ++ai)
#pragma unroll
                for (int m = 0; m < 4; ++m) {
                    const f32x4 v0 = acc[ai][bj][m][0] * SC + b0, v1 = acc[ai][bj][m][1] * SC + b1;
                    v4u w; w.x = pg8::cvt_pk_bf16(v0[0], v0[1]); w.y = pg8::cvt_pk_bf16(v0[2], v0[3]); w.z = pg8::cvt_pk_bf16(v1[0], v1[1]); w.w = pg8::cvt_pk_bf16(v1[2], v1[3]);
                    *(v4u*)(U + (size_t)(row0 + ai * 128 + m * 16) * 512 + cc) = w; }
        }
    }
};

__device__ __forceinline__ unsigned pk4_fp8(float a, float b, float c, float d) { int w = __builtin_amdgcn_cvt_pk_fp8_f32(a, b, 0, false); w = __builtin_amdgcn_cvt_pk_fp8_f32(c, d, w, true); return (unsigned)w; }
struct PolP3 {
    static constexpr bool FP8 = false, UNIFORM_A = false, UNIFORM_B = false;
    static constexpr bool PERM = true;
    const char *A0, *B0, *A1, *B1; const float* bo; const bf16* G; unsigned char* O; int G_, c;
    __device__ __forceinline__ bool next(int i, pg8::Unit& u) const {
        int pm, pn; if (!pg8::tile_order(NTOK / 256, D / 256, G_, c, i >> 1, pm, pn)) return false;
        u.pm = pm; u.pn = pn; u.kind = i & 1; u.e = 0; u.r0 = 0; u.aux = 0;
        if (u.kind == 0) { u.A = A0 + (size_t)pm * 256 * 2048; u.B = B0 + (size_t)pn * 256 * 2048; u.nt = 16; u.ldb = 2048; }
        else { u.A = A1 + (size_t)pm * 256 * 1024; u.B = B1 + (size_t)pn * 256 * 1024; u.nt = 8; u.ldb = 1024; }
        return true; }
    __device__ __forceinline__ void lane_issue(const pg8::Unit&, int, int (&)[2][2]) const {}
    __device__ __forceinline__ void lane_issue_asm(const pg8::Unit&, int, int (&)[2][2]) const {}
    __device__ __forceinline__ void lane_finish(const pg8::Unit& u, int tid_, const int (&)[2][2], unsigned (&va)[2][2]) const {
        int R[2], C2[2];
#pragma unroll
        for (int i_ = 0; i_ < 2; ++i_) { int C_; pg8::stage_rc(tid_ * 16 + i_ * 8192, R[i_], C_); C2[i_] = C_ * 2; }
        const int lda = u.kind == 0 ? 2048 : 1024;
#pragma unroll
        for (int h = 0; h < 2; ++h) { va[h][0] = (unsigned)((R[0] + 128 * h) * lda + C2[0]); va[h][1] = (unsigned)((R[1] + 128 * h) * lda + C2[1]); } }
    __device__ __forceinline__ bool keep_acc(const pg8::Unit& u) const { return u.kind == 0; }
    __device__ __forceinline__ void epilogue(f32x4 (&acc)[2][2][4][2], const pg8::Unit& u, int wr, int wc, int fr, int fq) const {
        const int row0 = u.pm * 256 + wr * 64 + fr;
        const int cc0 = u.pn * 256 + wc * 32 + 8 * fq;
        if (u.kind == 0) {
            f32x4 bb[2][2];
#pragma unroll
            for (int bj = 0; bj < 2; ++bj) { bb[bj][0] = *(const f32x4*)(bo + cc0 + bj * 128); bb[bj][1] = *(const f32x4*)(bo + cc0 + bj * 128 + 4); }
#pragma unroll
            for (int ai = 0; ai < 2; ++ai) {
                v4u g0[4][2];
#pragma unroll
                for (int m = 0; m < 4; ++m)
#pragma unroll
                    for (int bj = 0; bj < 2; ++bj) g0[m][bj] = __builtin_nontemporal_load((const v4u*)(G + (size_t)(row0 + ai * 128 + m * 16) * 2048 + cc0 + bj * 128));
#pragma unroll
                for (int m = 0; m < 4; ++m)
#pragma unroll
                    for (int bj = 0; bj < 2; ++bj) {
                        const v4u a0 = g0[m][bj];
                        f32x4 v0 = acc[ai][bj][m][0] + bb[bj][0], v1 = acc[ai][bj][m][1] + bb[bj][1];
                        v0[0] *= bflo(a0.x); v0[1] *= bfhi(a0.x); v0[2] *= bflo(a0.y); v0[3] *= bfhi(a0.y);
                        v1[0] *= bflo(a0.z); v1[1] *= bfhi(a0.z); v1[2] *= bflo(a0.w); v1[3] *= bfhi(a0.w);
                        acc[ai][bj][m][0] = v0; acc[ai][bj][m][1] = v1; }
            }
        } else {
            v4u g1[2][4][2];
#pragma unroll
            for (int ai = 0; ai < 2; ++ai)
#pragma unroll
                for (int m = 0; m < 4; ++m)
#pragma unroll
                    for (int bj = 0; bj < 2; ++bj) g1[ai][m][bj] = __builtin_nontemporal_load((const v4u*)(G + (size_t)(row0 + ai * 128 + m * 16) * 2048 + 1024 + cc0 + bj * 128));
#pragma unroll
            for (int ai = 0; ai < 2; ++ai)
#pragma unroll
                for (int mp = 0; mp < 2; ++mp)
#pragma unroll
                    for (int bj = 0; bj < 2; ++bj) {
                        v2u wq[2];
#pragma unroll
                        for (int mm = 0; mm < 2; ++mm) { const int m = 2 * mp + mm;
                            const v4u a1 = g1[ai][m][bj];
                            const f32x4 v0 = acc[ai][bj][m][0] * 8.0f, v1 = acc[ai][bj][m][1] * 8.0f;
                            wq[mm].x = pk4_fp8(v0[0] * bflo(a1.x), v0[1] * bfhi(a1.x), v0[2] * bflo(a1.y), v0[3] * bfhi(a1.y));
                            wq[mm].y = pk4_fp8(v1[0] * bflo(a1.z), v1[1] * bfhi(a1.z), v1[2] * bflo(a1.w), v1[3] * bfhi(a1.w)); }
                        const v2u r0 = __builtin_amdgcn_permlane16_swap(wq[0].x, wq[1].x, false, false), r1 = __builtin_amdgcn_permlane16_swap(wq[0].y, wq[1].y, false, false);
                        const int rr = u.pm * 256 + wr * 64 + ai * 128 + (2 * mp + (fq & 1)) * 16 + fr;
                        *(v4u*)(O + (size_t)rr * 1024 + cc0 + bj * 128 - 8 * (fq & 1)) = (v4u){r0.x, r1.x, r0.y, r1.y}; }
        }
    }
};

struct PolP4 {
    static constexpr bool FP8 = true, UNIFORM_A = true, UNIFORM_B = true;
    static constexpr float SC = 1.0f / 512.0f;
    static constexpr bool PERM = true;
    const char* A; const char* B; const float* x; bf16* out; float* ssp; int G_, c;
    __device__ __forceinline__ bool next(int i, pg8::Unit& u) const {
        int pm, pn; if (!pg8::tile_order(NTOK / 256, D / 256, G_, c, i, pm, pn)) return false;
        u.pm = pm; u.pn = pn; u.A = A + (size_t)pm * 256 * 1024; u.B = B + (size_t)pn * 256 * 1024; u.nt = 8; u.ldb = 1024; u.kind = 0; u.e = 0; u.r0 = 0; u.aux = 0; return true; }
    __device__ __forceinline__ void lane_issue(const pg8::Unit&, int, int (&)[2][2]) const {}
    __device__ __forceinline__ void lane_issue_asm(const pg8::Unit&, int, int (&)[2][2]) const {}
    __device__ __forceinline__ void lane_finish(const pg8::Unit&, int tid_, const int (&)[2][2], unsigned (&va)[2][2]) const {
        int R[2], C2[2];
#pragma unroll
        for (int i_ = 0; i_ < 2; ++i_) { int C_; pg8::stage_rc(tid_ * 16 + i_ * 8192, R[i_], C_); C2[i_] = C_ * 2; }
#pragma unroll
        for (int h = 0; h < 2; ++h) { va[h][0] = (unsigned)((R[0] + 128 * h) * 1024 + C2[0]); va[h][1] = (unsigned)((R[1] + 128 * h) * 1024 + C2[1]); } }
    __device__ __forceinline__ bool keep_acc(const pg8::Unit&) const { return false; }
    __device__ __forceinline__ void epilogue(f32x4 (&acc)[2][2][4][2], const pg8::Unit& u, int wr, int wc, int fr, int fq) const {
        const int row0 = u.pm * 256 + wr * 64 + fr, col0 = u.pn * 256 + wc * 32 + 8 * fq;
#pragma unroll
        for (int ai = 0; ai < 2; ++ai) {
            f32x4 xv[4][2][2];
#pragma unroll
            for (int m = 0; m < 4; ++m)
#pragma unroll
                for (int bj = 0; bj < 2; ++bj)
#pragma unroll
                    for (int n = 0; n < 2; ++n) xv[m][bj][n] = __builtin_nontemporal_load((const f32x4*)(x + (size_t)(row0 + ai * 128 + m * 16) * D + col0 + bj * 128 + n * 4));
#pragma unroll
            for (int m = 0; m < 4; ++m) { const size_t off = (size_t)(row0 + ai * 128 + m * 16) * D + col0; float ss = 0.f;
#pragma unroll
                for (int bj = 0; bj < 2; ++bj) { const f32x4 o0 = acc[ai][bj][m][0] * SC + xv[m][bj][0], o1 = acc[ai][bj][m][1] * SC + xv[m][bj][1];
                    ss += ((o0[0] * o0[0] + o0[1] * o0[1]) + (o0[2] * o0[2] + o0[3] * o0[3])) + ((o1[0] * o1[0] + o1[1] * o1[1]) + (o1[2] * o1[2] + o1[3] * o1[3]));
                    v4u w; w.x = pg8::cvt_pk_bf16(o0[0], o0[1]); w.y = pg8::cvt_pk_bf16(o0[2], o0[3]); w.z = pg8::cvt_pk_bf16(o1[0], o1[1]); w.w = pg8::cvt_pk_bf16(o1[2], o1[3]);
                    *(v4u*)(out + off + bj * 128) = w; }
                ss += __shfl_xor(ss, 16); ss += __shfl_xor(ss, 32);
                if (fq == 0) ssp[(size_t)(row0 + ai * 128 + m * 16) * 16 + u.pn * 4 + wc] = ss; }
        }
    }
};

struct PolP7 {
    static constexpr bool FP8 = true, UNIFORM_A = false, UNIFORM_B = true;
    static constexpr bool PERM = true;
    const char* H2; const char* W; const int* ltok; const float* bg; const float* bu; unsigned char* a; const LAS int* tab; const LAS unsigned* rbmap; int G_, c;
    __device__ __forceinline__ bool next(int i, pg8::Unit& u) const {
        const int nrb = __builtin_amdgcn_readfirstlane(tab[T_NRBTOT]); int pm, pn; if (!pg8::tile_order(nrb, 8, G_, c, i, pm, pn)) return false;
        const unsigned m = (unsigned)__builtin_amdgcn_readfirstlane((int)rbmap[pm]); const int e = (int)(m >> 16), rb = (int)(m & 0xffffu);
        u.pm = pm; u.pn = pn; u.e = e; u.r0 = rb * 256; u.A = H2; u.B = W + ((size_t)e * 2048 + (size_t)pn * 256) * 1024; u.nt = 8; u.ldb = 1024; u.kind = 0; u.aux = 0; return true; }
    __device__ __forceinline__ void lane_issue(const pg8::Unit& u, int tid_, int (&idx)[2][2]) const {
        int R[2];
#pragma unroll
        for (int i_ = 0; i_ < 2; ++i_) { int C_; pg8::stage_rc(tid_ * 16 + i_ * 8192, R[i_], C_); }
        const int e = u.e, c0 = tab[T_CNT0 + e], c1 = tab[T_CNT1 + e];
#pragma unroll
        for (int h = 0; h < 2; ++h)
#pragma unroll
            for (int i = 0; i < 2; ++i) { const int rr = u.r0 + R[i] + 128 * h; const bool in0 = rr < c0, in1 = rr < c0 + c1;
                int li = in0 ? e * LCAP + rr : (NE + e) * LCAP + (rr - c0); li = in1 ? li : e * LCAP; idx[h][i] = ltok[li]; } }
    __device__ __forceinline__ void lane_issue_asm(const pg8::Unit& u, int tid_, int (&idx)[2][2]) const {
        int R[2];
#pragma unroll
        for (int i_ = 0; i_ < 2; ++i_) { int C_; pg8::stage_rc(tid_ * 16 + i_ * 8192, R[i_], C_); }
        const int e = u.e, c0 = tab[T_CNT0 + e], c1 = tab[T_CNT1 + e];
#pragma unroll
        for (int h = 0; h < 2; ++h)
#pragma unroll
            for (int i = 0; i < 2; ++i) { const int rr = u.r0 + R[i] + 128 * h; const bool in0 = rr < c0, in1 = rr < c0 + c1;
                int li = in0 ? e * LCAP + rr : (NE + e) * LCAP + (rr - c0); li = in1 ? li : e * LCAP; const unsigned boff = (unsigned)li * 4u;
                asm volatile("global_load_dword %0, %1, %2" : "=&v"(idx[h][i]) : "v"(boff), "s"(ltok) : "memory"); } }
    __device__ __forceinline__ void lane_finish(const pg8::Unit& u, int tid_, const int (&idx)[2][2], unsigned (&va)[2][2]) const {
        int R[2], C2[2];
#pragma unroll
        for (int i_ = 0; i_ < 2; ++i_) { int C_; pg8::stage_rc(tid_ * 16 + i_ * 8192, R[i_], C_); C2[i_] = C_ * 2; }
        const int e = u.e, c0 = tab[T_CNT0 + e], c1 = tab[T_CNT1 + e];
#pragma unroll
        for (int h = 0; h < 2; ++h)
#pragma unroll
            for (int i = 0; i < 2; ++i) { const int rr = u.r0 + R[i] + 128 * h; const bool in1 = rr < c0 + c1; va[h][i] = (unsigned)((in1 ? (idx[h][i] >> 2) : 0) * 1024 + C2[i]); } }
    __device__ __forceinline__ bool keep_acc(const pg8::Unit&) const { return false; }
    __device__ __forceinline__ void epilogue(f32x4 (&acc)[2][2][4][2], const pg8::Unit& u, int wr, int wc, int fr, int fq) const {
        const int e = u.e, ps = tab[T_PSTART + e];
        const int ff = u.pn * 128 + wc * 32 + 8 * fq;
        const f32x4 g0 = *(const f32x4*)(bg + e * DFF + ff), g1 = *(const f32x4*)(bg + e * DFF + ff + 4), u0 = *(const f32x4*)(bu + e * DFF + ff), u1 = *(const f32x4*)(bu + e * DFF + ff + 4);
        const f32x2 scg = {1.0f / 64.0f, 1.0f / 64.0f}, scu = {4.0f / 64.0f, 4.0f / 64.0f}, kk = {-1.702f * 1.4426950408889634f, -1.702f * 1.4426950408889634f}, one = {1.0f, 1.0f};
        f32x2 bgp[4], bup[4];
        bgp[0] = (f32x2){g0[0], g0[1]}; bgp[1] = (f32x2){g0[2], g0[3]}; bgp[2] = (f32x2){g1[0], g1[1]}; bgp[3] = (f32x2){g1[2], g1[3]};
        bup[0] = (f32x2){4.f * u0[0] + 4.f, 4.f * u0[1] + 4.f}; bup[1] = (f32x2){4.f * u0[2] + 4.f, 4.f * u0[3] + 4.f}; bup[2] = (f32x2){4.f * u1[0] + 4.f, 4.f * u1[1] + 4.f}; bup[3] = (f32x2){4.f * u1[2] + 4.f, 4.f * u1[3] + 4.f};
#pragma unroll
        for (int ai = 0; ai < 2; ++ai)
#pragma unroll
            for (int mp = 0; mp < 2; ++mp) {
                v2u wq[2];
#pragma unroll
                for (int mm = 0; mm < 2; ++mm) { const int m = 2 * mp + mm;
                    f32x2 o[4];
#pragma unroll
                    for (int q = 0; q < 4; ++q) {
                        const f32x4 ga = acc[ai][0][m][q >> 1], ua = acc[ai][1][m][q >> 1];
                        f32x2 g = (q & 1) ? (f32x2){ga[2], ga[3]} : (f32x2){ga[0], ga[1]}, uu = (q & 1) ? (f32x2){ua[2], ua[3]} : (f32x2){ua[0], ua[1]};
                        g = g * scg + bgp[q]; uu = uu * scu + bup[q];
                        g.x = fminf(g.x, 7.0f); g.y = fminf(g.y, 7.0f);
                        uu.x = __builtin_amdgcn_fmed3f(uu.x, -24.0f, 32.0f); uu.y = __builtin_amdgcn_fmed3f(uu.y, -24.0f, 32.0f);
                        f32x2 t = g * kk; t.x = __builtin_amdgcn_exp2f(t.x); t.y = __builtin_amdgcn_exp2f(t.y);
                        t = t + one; t.x = __builtin_amdgcn_rcpf(t.x); t.y = __builtin_amdgcn_rcpf(t.y);
                        o[q] = (g * t) * uu; }
                    wq[mm].x = pk4_fp8(o[0].x, o[0].y, o[1].x, o[1].y); wq[mm].y = pk4_fp8(o[2].x, o[2].y, o[3].x, o[3].y); }
                const v2u r0 = __builtin_amdgcn_permlane16_swap(wq[0].x, wq[1].x, false, false), r1 = __builtin_amdgcn_permlane16_swap(wq[0].y, wq[1].y, false, false);
                const int rr = u.r0 + ai * 128 + wr * 64 + (2 * mp + (fq & 1)) * 16 + fr;
                *(v4u*)(a + (size_t)(ps + rr) * DFF + (ff - 8 * (fq & 1))) = (v4u){r0.x, r1.x, r0.y, r1.y}; }
    }
};

struct PolP8 {
    static constexpr bool FP8 = true, UNIFORM_A = true, UNIFORM_B = true;
    static constexpr bool PERM = true;
    const char* Aa; const char* W; const int* ltok; const float* bd; unsigned char* Y; const LAS int* tab; const LAS unsigned* rbmap; int G_, c;
    __device__ __forceinline__ bool next(int i, pg8::Unit& u) const {
        const int nrb = __builtin_amdgcn_readfirstlane(tab[T_NRBTOT]); int pm, pn; if (!pg8::tile_order(nrb, 4, G_, c, i, pm, pn)) return false;
        const unsigned m = (unsigned)__builtin_amdgcn_readfirstlane((int)rbmap[pm]); const int e = (int)(m >> 16), rb = (int)(m & 0xffffu);
        const int arow = __builtin_amdgcn_readfirstlane(tab[T_PSTART + e]) + rb * 256;
        u.pm = pm; u.pn = pn; u.e = e; u.r0 = rb * 256; u.A = Aa + (size_t)arow * 1024; u.B = W + ((size_t)e * 1024 + (size_t)pn * 256) * 1024; u.nt = 8; u.ldb = 1024; u.kind = 0; u.aux = 0; return true; }
    __device__ __forceinline__ void lane_issue(const pg8::Unit&, int, int (&)[2][2]) const {}
    __device__ __forceinline__ void lane_issue_asm(const pg8::Unit&, int, int (&)[2][2]) const {}
    __device__ __forceinline__ void lane_finish(const pg8::Unit&, int tid_, const int (&)[2][2], unsigned (&va)[2][2]) const {
        int R[2], C2[2];
#pragma unroll
        for (int i_ = 0; i_ < 2; ++i_) { int C_; pg8::stage_rc(tid_ * 16 + i_ * 8192, R[i_], C_); C2[i_] = C_ * 2; }
#pragma unroll
        for (int h = 0; h < 2; ++h) { va[h][0] = (unsigned)((R[0] + 128 * h) * 1024 + C2[0]); va[h][1] = (unsigned)((R[1] + 128 * h) * 1024 + C2[1]); } }
    __device__ __forceinline__ bool keep_acc(const pg8::Unit&) const { return false; }
    __device__ __forceinline__ void epilogue(f32x4 (&acc)[2][2][4][2], const pg8::Unit& u, int wr, int wc, int fr, int fq) const {
        const int e = u.e, c0 = tab[T_CNT0 + e], c1 = tab[T_CNT1 + e];
        const int cc0 = u.pn * 256 + wc * 32 + 8 * fq;
        f32x4 bb[2][2]; int dstp[2][2];
#pragma unroll
        for (int bj = 0; bj < 2; ++bj) { bb[bj][0] = *(const f32x4*)(bd + e * D + cc0 + bj * 128); bb[bj][1] = *(const f32x4*)(bd + e * D + cc0 + bj * 128 + 4); }
#pragma unroll
        for (int ai = 0; ai < 2; ++ai)
#pragma unroll
            for (int mp = 0; mp < 2; ++mp) { const int rr = u.r0 + ai * 128 + wr * 64 + (2 * mp + (fq & 1)) * 16 + fr; const bool in0 = rr < c0, in1 = rr < c0 + c1;
                int li = in0 ? e * LCAP + rr : (NE + e) * LCAP + (rr - c0); li = in1 ? li : e * LCAP; dstp[ai][mp] = ltok[li]; }
        const float sc = 8.0f / 256.0f;
#pragma unroll
        for (int bj = 0; bj < 2; ++bj) { bb[bj][0] *= 8.0f; bb[bj][1] *= 8.0f; }
#pragma unroll
        for (int ai = 0; ai < 2; ++ai)
#pragma unroll
            for (int mp = 0; mp < 2; ++mp) {
                const int msel = 2 * mp + (fq & 1);
                const int rr = u.r0 + ai * 128 + wr * 64 + msel * 16 + fr;
                const int d_ = dstp[ai][mp];
#pragma unroll
                for (int bj = 0; bj < 2; ++bj) {
                    v2u wq[2];
#pragma unroll
                    for (int mm = 0; mm < 2; ++mm) { const int m = 2 * mp + mm;
                        const f32x4 v0 = acc[ai][bj][m][0] * sc + bb[bj][0], v1 = acc[ai][bj][m][1] * sc + bb[bj][1];
                        wq[mm].x = pk4_fp8(v0[0], v0[1], v0[2], v0[3]); wq[mm].y = pk4_fp8(v1[0], v1[1], v1[2], v1[3]); }
                    const v2u r0 = __builtin_amdgcn_permlane16_swap(wq[0].x, wq[1].x, false, false), r1 = __builtin_amdgcn_permlane16_swap(wq[0].y, wq[1].y, false, false);
                    if (rr < c0 + c1) *(v4u*)(Y + (size_t)d_ * D + cc0 + bj * 128 - 8 * (fq & 1)) = (v4u){r0.x, r1.x, r0.y, r1.y}; }
            }
    }
};

__device__ __forceinline__ float wave_sum(float v) {
#pragma unroll
    for (int o = 1; o < 64; o <<= 1) v += __shfl_xor(v, o);
    return v;
}
__device__ __forceinline__ void transpose_item(const float* W, int K, int N, bf16* WT, int k0, int n0, int drow0, LAS float* scr, int lane) {
#pragma unroll 8
    for (int i = 0; i < 32; ++i) { const int kk = 2 * i + (lane >> 5); scr[kk * 33 + (lane & 31)] = __builtin_nontemporal_load(W + (size_t)(k0 + kk) * N + n0 + (lane & 31)); }
    LDS_WAIT(); asm volatile("" ::: "memory");
    const int c = lane & 7;
#pragma unroll
    for (int j = 0; j < 4; ++j) { const int n = (lane >> 3) + 8 * j; const LAS float* s = scr + (8 * c) * 33 + n;
        v4u o; o.x = pk2(s[0 * 33], s[1 * 33]); o.y = pk2(s[2 * 33], s[3 * 33]); o.z = pk2(s[4 * 33], s[5 * 33]); o.w = pk2(s[6 * 33], s[7 * 33]);
        *(v4u*)(WT + (size_t)(drow0 + n) * K + k0 + 8 * c) = o; }
    LDS_WAIT(); asm volatile("" ::: "memory");
}
__device__ __forceinline__ void transpose_item8(const float* W, int K, int N, unsigned char* WT, int k0, int n0, int drow0, float scale, LAS float* scr, int lane) {
#pragma unroll 8
    for (int i = 0; i < 32; ++i) { const int kk = 2 * i + (lane >> 5); scr[kk * 33 + (lane & 31)] = __builtin_nontemporal_load(W + (size_t)(k0 + kk) * N + n0 + (lane & 31)); }
    LDS_WAIT(); asm volatile("" ::: "memory");
    const int c = lane & 7;
#pragma unroll
    for (int j = 0; j < 4; ++j) { const int n = (lane >> 3) + 8 * j; const LAS float* s = scr + (8 * c) * 33 + n;
        v2u o; o.x = pk4_fp8(s[0 * 33] * scale, s[1 * 33] * scale, s[2 * 33] * scale, s[3 * 33] * scale); o.y = pk4_fp8(s[4 * 33] * scale, s[5 * 33] * scale, s[6 * 33] * scale, s[7 * 33] * scale);
        *(v2u*)(WT + (size_t)(drow0 + n) * K + k0 + 8 * c) = o; }
    LDS_WAIT(); asm volatile("" ::: "memory");
}
__device__ __forceinline__ int qk_perm_d(int p) { const int j = (p >> 3) & 7, i = p & 7; return (p & ~63) + 4 * j + (i & 3) + 32 * (i >> 2); }
__device__ __forceinline__ void transpose_item_qk(const float* W, int K, int N, bf16* WT, int k0, int n0, LAS float* scr, int lane) {
    const int p = n0 + (lane & 31); const int srcc = (n0 < 1152) ? qk_perm_d(p) : p;
#pragma unroll 8
    for (int i = 0; i < 32; ++i) { const int kk = 2 * i + (lane >> 5); scr[kk * 33 + (lane & 31)] = __builtin_nontemporal_load(W + (size_t)(k0 + kk) * N + srcc); }
    LDS_WAIT(); asm volatile("" ::: "memory");
    const int c = lane & 7;
#pragma unroll
    for (int j = 0; j < 4; ++j) { const int n = (lane >> 3) + 8 * j; const LAS float* s = scr + (8 * c) * 33 + n;
        v4u o; o.x = pk2(s[0 * 33], s[1 * 33]); o.y = pk2(s[2 * 33], s[3 * 33]); o.z = pk2(s[4 * 33], s[5 * 33]); o.w = pk2(s[6 * 33], s[7 * 33]);
        *(v4u*)(WT + (size_t)(n0 + n) * K + k0 + 8 * c) = o; }
    LDS_WAIT(); asm volatile("" ::: "memory");
}
__device__ __forceinline__ void transpose_item_qk8(const float* W, int K, int N, unsigned char* WT, int k0, int n0, LAS float* scr, int lane) {
    const int p = n0 + (lane & 31); int srcc = (n0 < 1152) ? qk_perm_d(p) : p;
    if (n0 >= 1792) { const int q = p - 1792; srcc = 1792 + ((q >> 7) & 1) * 1024 + (q >> 8) * 128 + (q & 127); }
#pragma unroll 8
    for (int i = 0; i < 32; ++i) { const int kk = 2 * i + (lane >> 5); scr[kk * 33 + (lane & 31)] = __builtin_nontemporal_load(W + (size_t)(k0 + kk) * N + srcc); }
    LDS_WAIT(); asm volatile("" ::: "memory");
    const int c = lane & 7;
#pragma unroll
    for (int j = 0; j < 4; ++j) { const int n = (lane >> 3) + 8 * j; const LAS float* s = scr + (8 * c) * 33 + n;
        v2u o; o.x = pk4_fp8(s[0 * 33] * 64.f, s[1 * 33] * 64.f, s[2 * 33] * 64.f, s[3 * 33] * 64.f); o.y = pk4_fp8(s[4 * 33] * 64.f, s[5 * 33] * 64.f, s[6 * 33] * 64.f, s[7 * 33] * 64.f);
        *(v2u*)(WT + (size_t)(n0 + n) * K + k0 + 8 * c) = o; }
    LDS_WAIT(); asm volatile("" ::: "memory");
}
__device__ __forceinline__ void transpose_item_plain8(const float* W, int K, int N, unsigned char* WT, int k0, int n0, LAS float* scr, int lane) {
#pragma unroll 8
    for (int i = 0; i < 32; ++i) { const int kk = 2 * i + (lane >> 5); scr[kk * 33 + (lane & 31)] = __builtin_nontemporal_load(W + (size_t)(k0 + kk) * N + n0 + (lane & 31)); }
    LDS_WAIT(); asm volatile("" ::: "memory");
    const int c = lane & 7;
#pragma unroll
    for (int j = 0; j < 4; ++j) { const int n = (lane >> 3) + 8 * j; const LAS float* s = scr + (8 * c) * 33 + n;
        v2u o; o.x = pk4_fp8(s[0 * 33] * 64.f, s[1 * 33] * 64.f, s[2 * 33] * 64.f, s[3 * 33] * 64.f); o.y = pk4_fp8(s[4 * 33] * 64.f, s[5 * 33] * 64.f, s[6 * 33] * 64.f, s[7 * 33] * 64.f);
        *(v2u*)(WT + (size_t)(n0 + n) * K + k0 + 8 * c) = o; }
    LDS_WAIT(); asm volatile("" ::: "memory");
}
__device__ __forceinline__ void transpose_item8w(const float* W, int N, unsigned char* WT, int k0, int n0, int drow0, float scale, LAS float* scr, int lane) {
#pragma unroll 16
    for (int i = 0; i < 64; ++i) { const int kk = 2 * i + (lane >> 5); scr[kk * 33 + (((lane & 31) + 20 * (i >> 3)) & 31)] = __builtin_nontemporal_load(W + (size_t)(k0 + kk) * N + n0 + (lane & 31)); }
    LDS_WAIT(); asm volatile("" ::: "memory");
    const int c = lane & 7;
#pragma unroll
    for (int j = 0; j < 4; ++j) { const int n = (lane >> 3) + 8 * j; const LAS float* s = scr + (16 * c) * 33 + ((n + 20 * c) & 31);
        v4u o; o.x = pk4_fp8(s[0 * 33] * scale, s[1 * 33] * scale, s[2 * 33] * scale, s[3 * 33] * scale); o.y = pk4_fp8(s[4 * 33] * scale, s[5 * 33] * scale, s[6 * 33] * scale, s[7 * 33] * scale);
        o.z = pk4_fp8(s[8 * 33] * scale, s[9 * 33] * scale, s[10 * 33] * scale, s[11 * 33] * scale); o.w = pk4_fp8(s[12 * 33] * scale, s[13 * 33] * scale, s[14 * 33] * scale, s[15 * 33] * scale);
        __builtin_nontemporal_store(o, (v4u*)(WT + (size_t)(drow0 + n) * 1024 + k0 + 16 * c)); }
    LDS_WAIT(); asm volatile("" ::: "memory");
}
__device__ __forceinline__ void transpose_mat(const float* W, int K, int N, bf16* WT, int item, LAS float* scr, int lane) {
    const int nblk = N / 32, kb = item / nblk, nb = item % nblk;
    transpose_item(W, K, N, WT, 64 * kb, 32 * nb, 32 * nb, scr, lane);
}

template <class R> __device__ __forceinline__ void conv_run(const Ptrs& P, LAS unsigned char* lds, int wave, int lane, int G, R&& released);
__device__ __forceinline__ void p0_prologue(const Ptrs& P, LAS unsigned char* lds, int wave, int lane, int G) {
    LAS float* scr = (LAS float*)(lds + wave * 17408);
    unsigned char* ws = P.ws;
    constexpr int I_IN = (D / 64) * (INW / 32), I_O = (D / 64) * (D / 32), I_UP = (POOLW / 64) * (D / 32), I_OUT = I_O, I_MIX = 4 * (128 / 64) * (128 / 32);
    constexpr int NITEMS = I_IN + I_O + I_UP + I_OUT + I_MIX;
    LAS int* rowctr = (LAS int*)(lds + MISC_OFF + 64);
    if (wave >= 3) {
        const int gw = blockIdx.x * 5 + (wave - 3), NGW = G * 5;
        for (int it = gw; it < NITEMS; it += NGW) {
            int r = it;
            if (r < I_IN) { const int nblk = INW / 32, kb = r / nblk, nb = r % nblk; transpose_item_qk8(P.w_in, D, INW, ws + WS_WIN, 64 * kb, 32 * nb, scr, lane); continue; } r -= I_IN;
            if (r < I_O) { transpose_mat(P.w_o, D, D, (bf16*)(ws + WS_WO), r, scr, lane); continue; } r -= I_O;
            if (r < I_UP) { transpose_mat(P.w_pool_up, POOLW, D, (bf16*)(ws + WS_WUP), r, scr, lane); continue; } r -= I_UP;
            if (r < I_OUT) { const int nblk = D / 32, kb = r / nblk, nb = r % nblk; transpose_item_plain8(P.w_out, D, D, ws + WS_WOUT, 64 * kb, 32 * nb, scr, lane); continue; } r -= I_OUT;
            { const int g = r / 8, q = r % 8; transpose_mat(P.w_pool_mix + (size_t)g * 128 * 128, 128, 128, (bf16*)(ws + WS_WMIX) + (size_t)g * 128 * 128, q, scr, lane); }
        }
        for (int i = gw * 64 + lane; i < D * NE; i += NGW * 64) { const int e = i / D, k = i % D; const float w = P.w_router[(size_t)k * NE + e];
            const unsigned hi = f2bf(w); const float lo = w - __builtin_bit_cast(float, hi << 16);
            ((bf16*)(ws + WS_WRHI))[i] = (bf16)hi; ((bf16*)(ws + WS_WRLO))[i] = (bf16)f2bf(lo); }
        for (int i = gw * 64 + lane; i < NTOK * 32; i += NGW * 64) { const int tok = i >> 5, fi = i & 31;
            const float inv_freq = powf(10000.0f, -(float)(2 * fi) / 64.0f);
            const float ang = (float)P.positions[tok] * inv_freq;
            double rev = (double)ang * 0.15915494309189535; rev -= rint(rev);
            const float rf = (float)rev;
            f32x2 cs; cs.x = __builtin_amdgcn_cosf(rf); cs.y = __builtin_amdgcn_sinf(rf);
            ((f32x2*)(ws + WS_ROPE))[i] = cs; }
        { const int ngb = (NTOK / 4 - (int)blockIdx.x + G - 1) / G;
          conv_run(P, lds, wave, lane, G, [&]() { return *(volatile LAS int*)rowctr >= ngb; }); }
    }
    unsigned char* H = ws + WS_RA;
    const f32x4* gr = (const f32x4*)P.norm_mix_g + lane;
    f32x4 gg[4];
#pragma unroll
    for (int j = 0; j < 4; ++j) gg[j] = gr[64 * j];
    constexpr int NGRP = NTOK / 4;
    auto grab = [&]() { int j = 0; if (lane == 0) j = __hip_atomic_fetch_add(rowctr, 1, __ATOMIC_RELAXED, __HIP_MEMORY_SCOPE_WORKGROUP); return blockIdx.x + G * __builtin_amdgcn_readfirstlane(j); };
#define P0_LOAD(DST, GI) do { const int m_ = (GI) < NGRP ? (GI) * 4 : 0; \
        _Pragma("unroll") for (int r = 0; r < 4; ++r) { const f32x4* xr = (const f32x4*)(P.x + (size_t)(m_ + r) * D) + lane; \
            _Pragma("unroll") for (int j = 0; j < 4; ++j) DST[r][j] = __builtin_nontemporal_load(xr + 64 * j); } } while (0)
    int grp = grab(), grp1 = grab();
    f32x4 v[4][4], v1[4][4];
    P0_LOAD(v, grp); P0_LOAD(v1, grp1);
    while (grp < NGRP) {
        const int m0 = grp * 4;
        const int grp2 = grab();
        f32x4 v2[4][4];
        P0_LOAD(v2, grp2);
#pragma unroll
        for (int r = 0; r < 4; ++r) { float s = 0.f;
#pragma unroll
            for (int j = 0; j < 4; ++j) s += (v[r][j].x * v[r][j].x + v[r][j].y * v[r][j].y) + (v[r][j].z * v[r][j].z + v[r][j].w * v[r][j].w);
            const float rstd = 1.0f / sqrtf(wave_sum(s) * (1.f / D) + RMS_EPS);
            unsigned* o8 = (unsigned*)(H + (size_t)(m0 + r) * D) + lane;
#pragma unroll
            for (int j = 0; j < 4; ++j) { const f32x4 g = gg[j]; o8[64 * j] = pk4_fp8(v[r][j].x * rstd * g.x, v[r][j].y * rstd * g.y, v[r][j].z * rstd * g.z, v[r][j].w * rstd * g.w); } }
#pragma unroll
        for (int r = 0; r < 4; ++r)
#pragma unroll
            for (int j = 0; j < 4; ++j) { v[r][j] = v1[r][j]; v1[r][j] = v2[r][j]; }
        grp = grp1; grp1 = grp2;
    }
#undef P0_LOAD
}

constexpr int AT_KSTR = 72, AT_VRS = 160, AT_NK = 208;
constexpr int AT_VOFF = 30720, AT_BUF = 64000;
static_assert(AT_NK * AT_KSTR * 2 <= AT_VOFF && AT_VOFF + AT_NK * AT_VRS <= AT_BUF && 2 * AT_BUF <= RING_BYTES, "attn lds");
__device__ __forceinline__ void attn_prefetch(const bf16* Kg, const bf16* Vg, int unit, int tid, v4u (&kr)[4], v4u (&vr)[4]) {
    const int qt64 = unit % (SEQ / 64), kvh = (unit / (SEQ / 64)) % NKVH, b = unit / ((SEQ / 64) * NKVH);
    const int t0 = qt64 * 64, tokbase = b * SEQ;
#pragma unroll
    for (int i = 0; i < 4; ++i) { const int task = tid + 512 * i; const int kl = task >> 3, ds = task & 7, sk = t0 - 128 + kl;
        const bool ok = (task < AT_NK * 8) && (sk >= 0) && (kl < 192);
        const size_t off = (size_t)(tokbase + (ok ? sk : 0)) * 128 + kvh * 64 + 8 * ds;
        const v4u kk = *(const v4u*)(Kg + off), vv = *(const v4u*)(Vg + off);
        kr[i] = ok ? kk : (v4u){0u, 0u, 0u, 0u}; vr[i] = ok ? vv : (v4u){0u, 0u, 0u, 0u}; }
}
#define AT_TR8(o, addr, OFF) asm volatile( \
    "ds_read_b64_tr_b16 %0, %8 offset:%9\n\tds_read_b64_tr_b16 %1, %8 offset:%10\n\tds_read_b64_tr_b16 %2, %8 offset:%11\n\tds_read_b64_tr_b16 %3, %8 offset:%12\n\t" \
    "ds_read_b64_tr_b16 %4, %8 offset:%13\n\tds_read_b64_tr_b16 %5, %8 offset:%14\n\tds_read_b64_tr_b16 %6, %8 offset:%15\n\tds_read_b64_tr_b16 %7, %8 offset:%16\n\ts_waitcnt lgkmcnt(0)" \
    : "=&v"(o[0][0]), "=&v"(o[0][1]), "=&v"(o[1][0]), "=&v"(o[1][1]), "=&v"(o[2][0]), "=&v"(o[2][1]), "=&v"(o[3][0]), "=&v"(o[3][1]) \
    : "v"(addr), "n"((OFF)), "n"((OFF) + 2560), "n"((OFF) + 32), "n"((OFF) + 2560 + 32), "n"((OFF) + 64), "n"((OFF) + 2560 + 64), "n"((OFF) + 96), "n"((OFF) + 2560 + 96) : "memory")
__device__ __forceinline__ void attn_phase(const Ptrs& P, LAS unsigned char* lds, int tid, int wave, int lane, int G) {
    const unsigned char* ws = P.ws;
    const bf16* Qg = (const bf16*)(ws + WS_Q); const bf16* Kg = (const bf16*)(ws + WS_K); const bf16* Vg = (const bf16*)(ws + WS_V);
    bf16* Og = (bf16*)(ws + WS_RA);
    constexpr int NU = NB * NKVH * (SEQ / 64);
    static_assert(NU % 8 == 0, "unit swizzle");
    auto umap = [&](int li_) { return (li_ & 7) * (NU / 8) + (li_ >> 3); };
    int li = blockIdx.x; if (li >= NU) return;
    int unit = umap(li);
    v4u kr[4], vr[4];
    attn_prefetch(Kg, Vg, unit, tid, kr, vr);
    int buf = 0;
    const int c = lane & 15, g = lane >> 4;
    const float NEG = -__builtin_inff();
    auto q_base = [&](int u_) { const int qt_ = u_ % (SEQ / 64), kv_ = (u_ / (SEQ / 64)) % NKVH, b_ = u_ / ((SEQ / 64) * NKVH);
        return Qg + (size_t)(b_ * SEQ + qt_ * 64 + c) * 1024 + (kv_ * 8 + wave) * 64 + 8 * g; };
    bf16x8 nq0, nq1, nb0, nb1;
    { const bf16* q_ = q_base(unit); nq0 = __builtin_nontemporal_load((const bf16x8*)q_); nq1 = __builtin_nontemporal_load((const bf16x8*)(q_ + 32));
      nb0 = __builtin_nontemporal_load((const bf16x8*)(q_ + (size_t)16 * 1024)); nb1 = __builtin_nontemporal_load((const bf16x8*)(q_ + (size_t)16 * 1024 + 32)); }
    for (; li < NU; li += G) {
        unit = umap(li); const int unit_n = umap(li + G < NU ? li + G : li);
        const int qt64 = unit % (SEQ / 64), kvh = (unit / (SEQ / 64)) % NKVH, b = unit / ((SEQ / 64) * NKVH);
        const int t0 = qt64 * 64, tokbase = b * SEQ;
        LAS bf16* Kl = (LAS bf16*)(lds + buf * AT_BUF); LAS unsigned char* Vl = lds + buf * AT_BUF + AT_VOFF;
        const int hq = kvh * 8 + wave;
        const bf16* qp0 = Qg + (size_t)(tokbase + t0 + c) * 1024 + hq * 64 + 8 * g;
        const bf16* qpn = q_base(unit_n);
#pragma unroll
        for (int i = 0; i < 4; ++i) { const int task = tid + 512 * i; const int kl = task >> 3, ds = task & 7;
            if (task < AT_NK * 8) { *(LAS v4u*)(Kl + kl * AT_KSTR + 8 * ds) = kr[i]; *(LAS v4u*)(Vl + kl * AT_VRS + 16 * ds) = vr[i]; } }
        if (li + G < NU) attn_prefetch(Kg, Vg, unit_n, tid, kr, vr);
        asm volatile("s_waitcnt lgkmcnt(0)" ::: "memory"); __builtin_amdgcn_s_barrier(); asm volatile("" ::: "memory");
        const float sink = P.sinks[hq] * 1.4426950408889634f;
        const unsigned vaddr0 = (unsigned)(size_t)Vl + (unsigned)((4 * g + ((lane & 15) >> 2)) * AT_VRS + 8 * (lane & 3));
#pragma unroll 1
        for (int pq = 0; pq < 2; ++pq) {
            const int qa = 2 * pq;
            const int toka = tokbase + t0 + 16 * qa + c;
            const bf16x8 a0 = nq0, a1 = nq1, b0 = nb0, b1 = nb1;
            { const bf16* qp = pq < 1 ? qp0 + (size_t)32 * 1024 : qpn;
              nq0 = __builtin_nontemporal_load((const bf16x8*)qp); nq1 = __builtin_nontemporal_load((const bf16x8*)(qp + 32));
              nb0 = __builtin_nontemporal_load((const bf16x8*)(qp + (size_t)16 * 1024)); nb1 = __builtin_nontemporal_load((const bf16x8*)(qp + (size_t)16 * 1024 + 32)); }
            f32x4 Sa[9], Sb[9];
#pragma unroll
            for (int u = 0; u < 10; ++u) {
                const LAS bf16* kp = Kl + (16 * (qa + u) + c) * AT_KSTR + 8 * g;
                const bf16x8 kf0 = *(const LAS bf16x8*)kp, kf1 = *(const LAS bf16x8*)(kp + 32);
                if (u < 9) { f32x4 sacc = {0.f, 0.f, 0.f, 0.f};
                    sacc = __builtin_amdgcn_mfma_f32_16x16x32_bf16(kf0, a0, sacc, 0, 0, 0); sacc = __builtin_amdgcn_mfma_f32_16x16x32_bf16(kf1, a1, sacc, 0, 0, 0); Sa[u] = sacc; }
                if (u > 0) { f32x4 sacc = {0.f, 0.f, 0.f, 0.f};
                    sacc = __builtin_amdgcn_mfma_f32_16x16x32_bf16(kf0, b0, sacc, 0, 0, 0); sacc = __builtin_amdgcn_mfma_f32_16x16x32_bf16(kf1, b1, sacc, 0, 0, 0); Sb[u - 1] = sacc; } }
#pragma unroll
            for (int r = 0; r < 4; ++r) { const bool lo = (c - 4 * g - r) < 0; Sa[0][r] = lo ? Sa[0][r] : NEG; Sa[8][r] = lo ? NEG : Sa[8][r]; Sb[0][r] = lo ? Sb[0][r] : NEG; Sb[8][r] = lo ? NEG : Sb[8][r]; }
            if (t0 < 128) {
#pragma unroll
                for (int tt = 0; tt < 9; ++tt)
#pragma unroll
                    for (int r = 0; r < 4; ++r) { const int sk = t0 - 128 + 16 * (qa + tt) + 4 * g + r; Sa[tt][r] = sk >= 0 ? Sa[tt][r] : NEG; Sb[tt][r] = (sk + 16) >= 0 ? Sb[tt][r] : NEG; } }
            float mxa = sink, mxb = sink;
#pragma unroll
            for (int tt = 0; tt < 9; ++tt) { mxa = fmaxf(fmaxf(mxa, fmaxf(Sa[tt][0], Sa[tt][1])), fmaxf(Sa[tt][2], Sa[tt][3])); mxb = fmaxf(fmaxf(mxb, fmaxf(Sb[tt][0], Sb[tt][1])), fmaxf(Sb[tt][2], Sb[tt][3])); }
            mxa = fmaxf(mxa, __shfl_xor(mxa, 16)); mxa = fmaxf(mxa, __shfl_xor(mxa, 32)); mxb = fmaxf(mxb, __shfl_xor(mxb, 16)); mxb = fmaxf(mxb, __shfl_xor(mxb, 32));
            float suma = 0.f, sumb = 0.f;
#pragma unroll
            for (int tt = 0; tt < 9; ++tt)
#pragma unroll
                for (int r = 0; r < 4; ++r) { const float pa = __builtin_amdgcn_exp2f(Sa[tt][r] - mxa); Sa[tt][r] = pa; suma += pa; const float pb = __builtin_amdgcn_exp2f(Sb[tt][r] - mxb); Sb[tt][r] = pb; sumb += pb; }
            suma += __shfl_xor(suma, 16); suma += __shfl_xor(suma, 32); sumb += __shfl_xor(sumb, 16); sumb += __shfl_xor(sumb, 32);
            suma += __builtin_amdgcn_exp2f(sink - mxa); sumb += __builtin_amdgcn_exp2f(sink - mxb);
            const float inva = 1.0f / suma, invb = 1.0f / sumb;
            f32x4 Oa[4], Ob[4];
#pragma unroll
            for (int dt = 0; dt < 4; ++dt) { Oa[dt] = (f32x4){0.f, 0.f, 0.f, 0.f}; Ob[dt] = (f32x4){0.f, 0.f, 0.f, 0.f}; }
            const unsigned vaddr = vaddr0 + (unsigned)(qa * 16 * AT_VRS);
#define AT_PK(x) pg8::cvt_pk_bf16((x)[0], (x)[1]), pg8::cvt_pk_bf16((x)[2], (x)[3])
#define AT_PV(ps) do { v2u vv[4][2]; AT_TR8(vv, vaddr, (ps) * 5120); \
                v4u pwa, pwb; { const unsigned t_[2] = {AT_PK(Sa[2 * (ps)])}; pwa.x = t_[0]; pwa.y = t_[1]; } \
                if ((ps) < 4) { const unsigned t_[2] = {AT_PK(Sa[(2 * (ps) + 1) % 9])}; pwa.z = t_[0]; pwa.w = t_[1]; } else { pwa.z = 0u; pwa.w = 0u; } \
                if ((ps) > 0) { const unsigned t_[2] = {AT_PK(Sb[(2 * (ps) + 8) % 9])}; pwb.x = t_[0]; pwb.y = t_[1]; } else { pwb.x = 0u; pwb.y = 0u; } \
                { const unsigned t_[2] = {AT_PK(Sb[2 * (ps)])}; pwb.z = t_[0]; pwb.w = t_[1]; } \
                const bf16x8 pfa = __builtin_bit_cast(bf16x8, pwa), pfb = __builtin_bit_cast(bf16x8, pwb); \
                _Pragma("unroll") for (int dt = 0; dt < 4; ++dt) { const bf16x8 vf = __builtin_bit_cast(bf16x8, (v4u){vv[dt][0].x, vv[dt][0].y, vv[dt][1].x, vv[dt][1].y}); \
                    Oa[dt] = __builtin_amdgcn_mfma_f32_16x16x32_bf16(vf, pfa, Oa[dt], 0, 0, 0); Ob[dt] = __builtin_amdgcn_mfma_f32_16x16x32_bf16(vf, pfb, Ob[dt], 0, 0, 0); } } while (0)
            AT_PV(0); AT_PV(1); AT_PV(2); AT_PV(3); AT_PV(4);
#undef AT_PV
#undef AT_PK
#pragma unroll
            for (int dp = 0; dp < 2; ++dp) {
                v2u xa, ya, xb, yb;
                xa.x = pg8::cvt_pk_bf16(Oa[2 * dp][0] * inva, Oa[2 * dp][1] * inva); xa.y = pg8::cvt_pk_bf16(Oa[2 * dp][2] * inva, Oa[2 * dp][3] * inva);
                ya.x = pg8::cvt_pk_bf16(Oa[2 * dp + 1][0] * inva, Oa[2 * dp + 1][1] * inva); ya.y = pg8::cvt_pk_bf16(Oa[2 * dp + 1][2] * inva, Oa[2 * dp + 1][3] * inva);
                xb.x = pg8::cvt_pk_bf16(Ob[2 * dp][0] * invb, Ob[2 * dp][1] * invb); xb.y = pg8::cvt_pk_bf16(Ob[2 * dp][2] * invb, Ob[2 * dp][3] * invb);
                yb.x = pg8::cvt_pk_bf16(Ob[2 * dp + 1][0] * invb, Ob[2 * dp + 1][1] * invb); yb.y = pg8::cvt_pk_bf16(Ob[2 * dp + 1][2] * invb, Ob[2 * dp + 1][3] * invb);
                const v2u a0_ = __builtin_amdgcn_permlane16_swap(xa.x, ya.x, false, false), a1_ = __builtin_amdgcn_permlane16_swap(xa.y, ya.y, false, false);
                const v2u b0_ = __builtin_amdgcn_permlane16_swap(xb.x, yb.x, false, false), b1_ = __builtin_amdgcn_permlane16_swap(xb.y, yb.y, false, false);
                const int dcol = hq * 64 + 16 * (2 * dp + (g & 1)) + 4 * (g & ~1);
                *(v4u*)(Og + (size_t)toka * 1024 + dcol) = (v4u){a0_.x, a1_.x, a0_.y, a1_.y};
                *(v4u*)(Og + (size_t)(toka + 16) * 1024 + dcol) = (v4u){b0_.x, b1_.x, b0_.y, b1_.y}; }
        }
        buf ^= 1;
    }
    asm volatile("s_waitcnt vmcnt(0) lgkmcnt(0)" ::: "memory"); __builtin_amdgcn_s_barrier(); asm volatile("" ::: "memory");
}
#undef AT_TR8

constexpr int PL_PSTR = 520;
template <int W>
__device__ __forceinline__ void pool_load(unsigned (&raw)[31], const bf16* Ug, int unit, int cp, int th) {
    const int tok0 = unit * 32, s0 = tok0 % SEQ, i0 = 16 * th;
#pragma unroll
    for (int j = 0; j < 15 + W; ++j) { const int ti = i0 - (W - 1) + j; const bool ok = s0 + ti >= 0;
        const unsigned v = *(const unsigned*)(Ug + (size_t)(tok0 + (ok ? ti : 0)) * 512 + 2 * cp); raw[j] = ok ? v : 0u; }
}
template <int W>
__device__ __forceinline__ void pool_slide(const unsigned (&raw)[31], LAS bf16* pl, int unit, int cp, int th) {
    const int tok0 = unit * 32, s0 = tok0 % SEQ, i0 = 16 * th;
    float sa = 0.f, sb = 0.f;
#pragma unroll
    for (int j = 0; j < W - 1; ++j) { sa += bflo(raw[j]); sb += bfhi(raw[j]); }
#pragma unroll
    for (int i = 0; i < 16; ++i) {
        const float ca = bflo(raw[i + W - 1]), cb = bfhi(raw[i + W - 1]);
        sa += ca; sb += cb;
        const int sp = s0 + i0 + i + 1; const float inv = sp < W ? __builtin_amdgcn_rcpf((float)sp) : (1.0f / (float)W);
        *(LAS unsigned*)(pl + (i0 + i) * PL_PSTR + 2 * cp) = pk2(sa * inv - ca, sb * inv - cb);
        sa -= bflo(raw[i]); sb -= bfhi(raw[i]);
    }
}
#define POOL_DISPATCH(fn, ...) do { if (sgrp == 0) fn<2>(__VA_ARGS__); else if (sgrp == 1) fn<4>(__VA_ARGS__); else if (sgrp == 2) fn<8>(__VA_ARGS__); else fn<16>(__VA_ARGS__); } while (0)
__device__ __forceinline__ void pool_phase(const Ptrs& P, LAS unsigned char* lds, int tid, int wave, int lane, int G) {
    const unsigned char* ws = P.ws;
    const bf16* Ug = (const bf16*)(ws + WS_U); const bf16* Wm = (const bf16*)(ws + WS_WMIX); bf16* Mx = (bf16*)(ws + WS_MIXED);
    constexpr int NU = NTOK / 32;
    int unit = blockIdx.x; if (unit >= NU) return;
    const int cp = tid & 255, th = tid >> 8, sgrp = wave & 3;
    const int grp = wave >> 1, nh = wave & 1, c = lane & 15, g = lane >> 4;
    bf16x8 wf[4][4];
#pragma unroll
    for (int s = 0; s < 4; ++s)
#pragma unroll
        for (int n = 0; n < 4; ++n) wf[s][n] = *(const bf16x8*)(Wm + ((size_t)grp * 128 + 16 * (4 * nh + n) + c) * 128 + 32 * s + 8 * g);
    f32x4 psc[4];
#pragma unroll
    for (int n = 0; n < 4; ++n) psc[n] = *(const f32x4*)(P.pool_scale + 128 * grp + 16 * (4 * nh + n) + 4 * g);
    unsigned raw[31];
    POOL_DISPATCH(pool_load, raw, Ug, unit, cp, th);
    int buf = 0;
    for (; unit < NU; unit += G) {
        LAS bf16* pl = (LAS bf16*)(lds + buf * 34816);
        POOL_DISPATCH(pool_slide, raw, pl, unit, cp, th);
        if (unit + G < NU) POOL_DISPATCH(pool_load, raw, Ug, unit + G, cp, th);
        asm volatile("s_waitcnt lgkmcnt(0)" ::: "memory"); __builtin_amdgcn_s_barrier(); asm volatile("" ::: "memory");
        const int tok0 = unit * 32;
        f32x4 acc[2][4];
#pragma unroll
        for (int mt = 0; mt < 2; ++mt)
#pragma unroll
            for (int n = 0; n < 4; ++n) acc[mt][n] = (f32x4){0.f, 0.f, 0.f, 0.f};
#pragma unroll
        for (int s = 0; s < 4; ++s) {
            bf16x8 pf[2];
#pragma unroll
            for (int mt = 0; mt < 2; ++mt) pf[mt] = *(const LAS bf16x8*)(pl + (16 * mt + c) * PL_PSTR + 128 * grp + 32 * s + 8 * g);
#pragma unroll
            for (int n = 0; n < 4; ++n)
#pragma unroll
                for (int mt = 0; mt < 2; ++mt) acc[mt][n] = __builtin_amdgcn_mfma_f32_16x16x32_bf16(wf[s][n], pf[mt], acc[mt][n], 0, 0, 0);
        }
#pragma unroll
        for (int np = 0; np < 2; ++np)
#pragma unroll
            for (int mt = 0; mt < 2; ++mt) { v2u x_, y_;
                x_.x = pk2(acc[mt][2 * np][0] * psc[2 * np].x, acc[mt][2 * np][1] * psc[2 * np].y); x_.y = pk2(acc[mt][2 * np][2] * psc[2 * np].z, acc[mt][2 * np][3] * psc[2 * np].w);
                y_.x = pk2(acc[mt][2 * np + 1][0] * psc[2 * np + 1].x, acc[mt][2 * np + 1][1] * psc[2 * np + 1].y); y_.y = pk2(acc[mt][2 * np + 1][2] * psc[2 * np + 1].z, acc[mt][2 * np + 1][3] * psc[2 * np + 1].w);
                const v2u r0 = __builtin_amdgcn_permlane16_swap(x_.x, y_.x, false, false), r1 = __builtin_amdgcn_permlane16_swap(x_.y, y_.y, false, false);
                const int d0 = 128 * grp + 16 * (4 * nh + 2 * np + (g & 1)) + 4 * (g & ~1);
                *(v4u*)(Mx + (size_t)(tok0 + 16 * mt + c) * 512 + d0) = (v4u){r0.x, r1.x, r0.y, r1.y}; }
        buf ^= 1;
    }
    asm volatile("s_waitcnt vmcnt(0) lgkmcnt(0)" ::: "memory"); __builtin_amdgcn_s_barrier(); asm volatile("" ::: "memory");
}
#undef POOL_DISPATCH

__device__ __forceinline__ void p5_rows(const Ptrs& P, LAS unsigned char* lds, int tid, int wave, int lane, int G, bool dispatch) {
    unsigned char* ws = P.ws;
    const bf16* X1 = (const bf16*)(ws + WS_X1B); unsigned char* H2 = ws + WS_H28;
    const bf16* Whi = (const bf16*)(ws + WS_WRHI); const bf16* Wlo = (const bf16*)(ws + WS_WRLO);
    int* ltok = (int*)(ws + WS_LTOK); const float* ssp = (const float*)(ws + WS_SSP); float* topw = (float*)(ws + WS_TOPW);
    unsigned* gcnt = (unsigned*)(ws + WS_CTL) + CW_GCNT;
    LAS int* tab = (LAS int*)(lds + TAB_OFF);
    LAS float* lg = (LAS float*)(lds + wave * 2304);
    const int r = lane & 15, g = lane >> 4;
    for (int g0 = blockIdx.x * NWAVES; g0 < NTOK / 16; g0 += G * NWAVES) {
        const int row = (g0 + wave) * 16 + r;
        const bf16* xp = X1 + (size_t)row * D + 8 * g;
        v4u xa[8];
#pragma unroll
        for (int j = 0; j < 8; ++j) xa[j] = __builtin_nontemporal_load((const v4u*)(xp + 32 * j));
        if (tid < 64) tab[T_LCNT + tid] = 0;
        for (int i = tid; i < 2 * 32 * 128; i += NWAVES * 64) { const int m = i >> 12, e = (i >> 7) & 31, ch = i & 127;
            const v4u w = *(const v4u*)((m ? Wlo : Whi) + (size_t)e * D + 8 * ch);
            *(LAS v4u*)(lds + m * 65536 + e * 2048 + ((ch ^ (e & 15)) << 4)) = w; }
        if (tid < 256) ((LAS f32x4*)(lds + P5_GAIN_OFF))[tid] = ((const f32x4*)P.norm_ffn_g)[tid];
        __syncthreads();
        f32x4 acc0 = {0.f, 0.f, 0.f, 0.f}, acc1 = {0.f, 0.f, 0.f, 0.f};
        float rstd;
        { const f32x4* sp = (const f32x4*)(ssp + (size_t)row * 16); const f32x4 s0 = sp[0], s1 = sp[1], s2 = sp[2], s3 = sp[3];
          const float ss = (((s0.x + s0.y) + (s0.z + s0.w)) + ((s1.x + s1.y) + (s1.z + s1.w))) + (((s2.x + s2.y) + (s2.z + s2.w)) + ((s3.x + s3.y) + (s3.z + s3.w)));
          rstd = 1.0f / sqrtf(ss * (1.f / D) + RMS_EPS); }
        const LAS unsigned char* wb0 = lds + r * 2048, * wb1 = lds + (16 + r) * 2048;
        v2u hprev = {0u, 0u};
        const LAS float* gl = (const LAS float*)(lds + P5_GAIN_OFF) + 8 * g;
#pragma unroll 1
        for (int sg = 0; sg < 4; ++sg) {
        v4u xb[8];
        { const int sn = sg < 3 ? sg + 1 : sg;
#pragma unroll
          for (int j = 0; j < 8; ++j) xb[j] = __builtin_nontemporal_load((const v4u*)(xp + 32 * (8 * sn + j))); }
#pragma unroll
        for (int sj = 0; sj < 8; ++sj) {
            const int s = 8 * sg + sj;
            const v4u xw = xa[sj];
            const f32x4 v0 = (f32x4){bflo(xw.x), bfhi(xw.x), bflo(xw.y), bfhi(xw.y)} * rstd, v1 = (f32x4){bflo(xw.z), bfhi(xw.z), bflo(xw.w), bfhi(xw.w)} * rstd;
            const f32x4 ga = *(const LAS f32x4*)(gl + 32 * s), gb = *(const LAS f32x4*)(gl + 32 * s + 4);
            const float p[8] = {v0.x * ga.x, v0.y * ga.y, v0.z * ga.z, v0.w * ga.w, v1.x * gb.x, v1.y * gb.y, v1.z * gb.z, v1.w * gb.w};
            unsigned hi[4], lo[4];
#pragma unroll
            for (int j = 0; j < 4; ++j) { const unsigned ha = f2bf(p[2 * j]), hb = f2bf(p[2 * j + 1]); hi[j] = ha | (hb << 16);
                lo[j] = pk2(p[2 * j] - __builtin_bit_cast(float, ha << 16), p[2 * j + 1] - __builtin_bit_cast(float, hb << 16)); }
            const v4u hv = {hi[0], hi[1], hi[2], hi[3]};
            { v2u h8; h8.x = pk4_fp8(p[0], p[1], p[2], p[3]); h8.y = pk4_fp8(p[4], p[5], p[6], p[7]);
              if (s & 1) { const v2u r0 = __builtin_amdgcn_permlane16_swap(hprev.x, h8.x, false, false), r1 = __builtin_amdgcn_permlane16_swap(hprev.y, h8.y, false, false);
                  *(v4u*)(H2 + (size_t)row * D + 32 * (s - 1 + (g & 1)) + 8 * (g & ~1)) = (v4u){r0.x, r1.x, r0.y, r1.y}; }
              else hprev = h8; }
            const bf16x8 ah = __builtin_bit_cast(bf16x8, hv), al = __builtin_bit_cast(bf16x8, (v4u){lo[0], lo[1], lo[2], lo[3]});
            const int co = (((4 * s + g) ^ r) << 4);
            const bf16x8 wh0 = *(const LAS bf16x8*)(wb0 + co), wh1 = *(const LAS bf16x8*)(wb1 + co);
            const bf16x8 wl0 = *(const LAS bf16x8*)(wb0 + 65536 + co), wl1 = *(const LAS bf16x8*)(wb1 + 65536 + co);
            acc0 = __builtin_amdgcn_mfma_f32_16x16x32_bf16(wh0, ah, acc0, 0, 0, 0); acc0 = __builtin_amdgcn_mfma_f32_16x16x32_bf16(wh0, al, acc0, 0, 0, 0); acc0 = __builtin_amdgcn_mfma_f32_16x16x32_bf16(wl0, ah, acc0, 0, 0, 0);
            acc1 = __builtin_amdgcn_mfma_f32_16x16x32_bf16(wh1, ah, acc1, 0, 0, 0); acc1 = __builtin_amdgcn_mfma_f32_16x16x32_bf16(wh1, al, acc1, 0, 0, 0); acc1 = __builtin_amdgcn_mfma_f32_16x16x32_bf16(wl1, ah, acc1, 0, 0, 0);
        }
#pragma unroll
        for (int j = 0; j < 8; ++j) xa[j] = xb[j];
        }
        int idx[4] = {0, 0, 0, 0}; float wgt[4] = {0.f, 0.f, 0.f, 0.f}; int rank[4] = {0, 0, 0, 0};
        float val[4];
        { const f32x4 b0 = *(const f32x4*)(P.b_router + 4 * g), b1 = *(const f32x4*)(P.b_router + 16 + 4 * g);
          const f32x4 l0 = acc0 + b0, l1 = acc1 + b1;
          float lv[8] = {l0.x, l0.y, l0.z, l0.w, l1.x, l1.y, l1.z, l1.w};
#pragma unroll
          for (int k = 0; k < 4; ++k) {
              float bv = lv[0]; int bi = 4 * g;
#pragma unroll
              for (int j = 1; j < 8; ++j) { const int ej = (j < 4 ? 4 * g + j : 16 + 4 * g + (j - 4)); const bool gt = lv[j] > bv; bv = gt ? lv[j] : bv; bi = gt ? ej : bi; }
#pragma unroll
              for (int m = 16; m <= 32; m <<= 1) { const float ov = __shfl_xor(bv, m); const int oi = __shfl_xor(bi, m); const bool take = (ov > bv) || (ov == bv && oi < bi); bv = take ? ov : bv; bi = take ? oi : bi; }
              val[k] = bv; idx[k] = bi;
#pragma unroll
              for (int j = 0; j < 8; ++j) { const int ej = (j < 4 ? 4 * g + j : 16 + 4 * g + (j - 4)); lv[j] = (ej == bi) ? -__builtin_inff() : lv[j]; } } }
        const int half = row >= HALF_TOK ? 1 : 0;
        if (lane < 16 && dispatch) {
            float den = 0.f;
#pragma unroll
            for (int k = 0; k < 4; ++k) { wgt[k] = __builtin_amdgcn_exp2f((val[k] - val[0]) * 1.4426950408889634f); den += wgt[k]; }
            const float id = 1.0f / den;
#pragma unroll
            for (int k = 0; k < 4; ++k) { wgt[k] *= id; rank[k] = __hip_atomic_fetch_add(tab + T_LCNT + half * 32 + idx[k], 1, __ATOMIC_RELAXED, __HIP_MEMORY_SCOPE_WORKGROUP); }
        }
        __syncthreads();
        if (tid < 64 && dispatch) { const int cn = tab[T_LCNT + tid]; int base = 0; if (cn > 0) base = (int)__hip_atomic_fetch_add(gcnt + tid * 16, (unsigned)cn, __ATOMIC_RELAXED, __HIP_MEMORY_SCOPE_AGENT); tab[T_LBASE + tid] = base; }
        __syncthreads();
        if (lane < 16 && dispatch) {
#pragma unroll
            for (int k = 0; k < 4; ++k) { const int pos = tab[T_LBASE + half * 32 + idx[k]] + rank[k];
                if (pos < LCAP) ltok[(size_t)(half * NE + idx[k]) * LCAP + pos] = row * 4 + k;
                topw[(size_t)row * 4 + k] = wgt[k]; }
        }
        __syncthreads();
    }
}

__device__ __forceinline__ void build_tables(const Ptrs& P, LAS unsigned char* lds, int tid, int mode) {
    const unsigned* gcnt = (const unsigned*)(P.ws + WS_CTL) + CW_GCNT;
    LAS int* tab = (LAS int*)(lds + TAB_OFF); LAS unsigned* rbmap = (LAS unsigned*)(lds + RBMAP_OFF);
    __syncthreads();
    if (tid < 64) { int v = (int)__hip_atomic_load(gcnt + tid * 16, __ATOMIC_RELAXED, __HIP_MEMORY_SCOPE_AGENT); v = v < LCAP ? v : LCAP; tab[(tid < 32 ? T_CNT0 : T_CNT1 - 32) + tid] = v; }
    __syncthreads();
    if (tid < 32) {
        int ps = 0, rs = 0;
        for (int e = 0; e < tid; ++e) { const int c0 = tab[T_CNT0 + e], c1 = tab[T_CNT1 + e]; ps += (c0 + c1 + 255) >> 8;
            rs += mode == 0 ? (c0 + c1 + 255) >> 8 : (mode == 1 ? (c0 + 255) >> 8 : (c1 + 255) >> 8); }
        const int c0 = tab[T_CNT0 + tid], c1 = tab[T_CNT1 + tid];
        const int mine = mode == 0 ? (c0 + c1 + 255) >> 8 : (mode == 1 ? (c0 + 255) >> 8 : (c1 + 255) >> 8);
        tab[T_PSTART + tid] = ps * 256;
        for (int rb = 0; rb < mine; ++rb) rbmap[rs + rb] = ((unsigned)tid << 16) | (unsigned)rb;
        if (tid == 31) tab[T_NRBTOT] = rs + mine;
    }
    __syncthreads();
}

constexpr int NCONV_GU = NE * 2 * 256, NCONV = NCONV_GU + NE * 256;
__device__ __forceinline__ void conv_item(const Ptrs& P, int it, LAS float* scr, int lane) {
    const bool gu = it < NCONV_GU; const int i2 = gu ? it : it - NCONV_GU;
    const int e = gu ? i2 >> 9 : i2 >> 8, sel = (i2 >> 8) & 1, q = i2 & 255, kb = q >> 5, n0 = 32 * (q & 31);
    const float* W = (gu ? (sel ? P.w_up : P.w_gate) : P.w_down) + (size_t)e * D * DFF;
    unsigned char* WT = gu ? P.ws + WS_WGU8 + (size_t)e * 2048 * 1024 : P.ws + WS_WD8 + (size_t)e * 1024 * 1024;
    const int drow = gu ? 256 * (n0 >> 7) + 128 * sel + (n0 & 127) : n0;
    transpose_item8w(W, DFF, WT, 128 * kb, n0, drow, 64.0f, scr, lane);
}
__device__ __forceinline__ unsigned conv_grab_v(unsigned* ctr, int lane) { unsigned v = 0; if (lane == 0) v = __hip_atomic_fetch_add(ctr, 1u, __ATOMIC_RELAXED, __HIP_MEMORY_SCOPE_AGENT); return v; }
template <class R>
__device__ __forceinline__ void conv_run(const Ptrs& P, LAS unsigned char* lds, int wave, int lane, int G, R&& released) {
    LAS float* scr = (LAS float*)(lds + wave * 17408);
    unsigned* ctr0 = (unsigned*)(P.ws + WS_CTL) + CW_CONV;
    const int NGW = G * NWAVES, jmax = 8 * ((NCONV + NGW - 1) / NGW);
    const int own = blockIdx.x, partner = (own + G / 2) % G;
    for (int side = 0; side < 2; ++side) {
        const int blk = side ? partner : own; unsigned* ctr = ctr0 + 16 * blk;
        for (;;) {
            if (released()) return;
            const int j = __builtin_amdgcn_readfirstlane((int)conv_grab_v(ctr, lane));
            if (j >= jmax) break;
            const int it = (j >> 3) * NGW + blk * 8 + (j & 7);
            if (it < NCONV) conv_item(P, it, scr, lane);
        }
    }
}

__device__ __forceinline__ void p9_rows(const Ptrs& P, int wave, int lane, int G) {
    const unsigned char* Y = P.ws + WS_Y; const float* topw = (const float*)(P.ws + WS_TOPW); const bf16* X1 = (const bf16*)(P.ws + WS_X1B);
    f32x4 gf[4];
#pragma unroll
    for (int t = 0; t < 4; ++t) gf[t] = *(const f32x4*)(P.norm_final_g + 256 * t + 4 * lane);
    v2u xw[4]; unsigned yv[4][4]; f32x4 w4;
    const unsigned lo4 = 4u * (unsigned)lane, lo8 = 8u * (unsigned)lane;
#define P9_LOAD(XW, YV, W4, R0) do { const int row = (R0); \
            _Pragma("unroll") for (int t = 0; t < 4; ++t) XW[t] = __builtin_nontemporal_load((const v2u*)((const unsigned char*)(X1 + (size_t)row * D + 256 * t) + lo8)); \
            W4 = *(const f32x4*)(topw + (size_t)row * 4); \
            _Pragma("unroll") for (int k = 0; k < 4; ++k) _Pragma("unroll") for (int t = 0; t < 4; ++t) YV[k][t] = __builtin_nontemporal_load((const unsigned*)(Y + ((size_t)row * 4 + k) * D + 256 * t + lo4)); } while (0)
    { const int r00 = blockIdx.x * NWAVES + wave; P9_LOAD(xw, yv, w4, (r00 < NTOK ? r00 : 0)); }
    for (int row = blockIdx.x * NWAVES + wave; row < NTOK; row += G * NWAVES) {
        v2u nxw[4]; unsigned nyv[4][4]; f32x4 nw4;
        { const int rn = (row + G * NWAVES < NTOK) ? row + G * NWAVES : row; P9_LOAD(nxw, nyv, nw4, rn); }
        {
            f32x4 v[4];
#pragma unroll
            for (int t = 0; t < 4; ++t) { const v2u x_ = xw[t]; v[t] = (f32x4){bflo(x_.x), bfhi(x_.x), bflo(x_.y), bfhi(x_.y)}; }
            const float wk[4] = {w4.x, w4.y, w4.z, w4.w};
#pragma unroll
            for (int k = 0; k < 4; ++k) { const float wq = wk[k] * 0.125f;
#pragma unroll
                for (int t = 0; t < 4; ++t) { const f32x2 a0 = __builtin_amdgcn_cvt_pk_f32_fp8((int)yv[k][t], false), a1 = __builtin_amdgcn_cvt_pk_f32_fp8((int)yv[k][t], true);
                    v[t].x += wq * a0.x; v[t].y += wq * a0.y; v[t].z += wq * a1.x; v[t].w += wq * a1.y; } }
            float s = 0.f;
#pragma unroll
            for (int t = 0; t < 4; ++t) s += (v[t].x * v[t].x + v[t].y * v[t].y) + (v[t].z * v[t].z + v[t].w * v[t].w);
            const float rstd = 1.0f / sqrtf(wave_sum(s) * (1.f / D) + RMS_EPS);
            float* xr = P.out + (size_t)row * D;
#pragma unroll
            for (int t = 0; t < 4; ++t) __builtin_nontemporal_store(v[t] * rstd * gf[t], (f32x4*)((unsigned char*)(xr + 256 * t) + 4u * lo4)); }
        w4 = nw4;
#pragma unroll
        for (int t = 0; t < 4; ++t) { xw[t] = nxw[t];
#pragma unroll
            for (int k = 0; k < 4; ++k) yv[k][t] = nyv[k][t]; }
    }
#undef P9_LOAD
}

struct Args { Ptrs p; int ph_lo, ph_hi; };
__global__ void __launch_bounds__(NWAVES * 64, 2) mk_fwd(Args args) {
    extern __shared__ __attribute__((aligned(16))) unsigned char lds_raw[];
    LAS unsigned char* lds = (LAS unsigned char*)lds_raw;
    const Ptrs& P = args.p;
    const int G = gridDim.x;
#define IDS() int tid = threadIdx.x; asm volatile("" : "+v"(tid)); const int lane = tid & 63, wave = __builtin_amdgcn_readfirstlane(tid >> 6); (void)lane; (void)wave
    for (int u = threadIdx.x; u < (LDS_BYTES - RING_BYTES) / 4; u += NWAVES * 64) ((LAS unsigned*)(lds + RING_BYTES))[u] = 0u;
    __syncthreads();
    unsigned* ctl = (unsigned*)(P.ws + WS_CTL);
    XcdBarrier bar; bar.bar = ctl + CW_BAR; bar.x = 0; bar.st = nullptr;
    if (N_LAUNCHES == 1) bar = xcd_barrier_post(ctl + CW_BAR, (volatile LAS unsigned*)(lds + MISC_OFF) + 8);
    const int lo = args.ph_lo, hi = args.ph_hi;
#ifndef PH_MASK
#define PH_MASK 0xFFF
#endif
#ifndef REP_MASK
#define REP_MASK 0
#endif
#define REPS(k) for (int rep_ = 0; rep_ < 1 + ((REP_MASK >> (k)) & 1); ++rep_)
#define IN(k) (((PH_MASK >> (k)) & 1) && lo <= (k) && (k) < hi)
#define SEAM(k) do { if (IN(k) && IN((k) + 1)) xcd_barrier(bar); } while (0)
#define SEAM_FILL(k) do { if (IN(k) && IN((k) + 1)) { IDS(); xcd_barrier_fill(bar, [&](auto&& rel) { conv_run(P, lds, wave, lane, G, rel); }); } } while (0)
    unsigned char* ws = P.ws;
    LAS int* tab = (LAS int*)(lds + TAB_OFF); LAS unsigned* rbmap = (LAS unsigned*)(lds + RBMAP_OFF);

    if (IN(0)) REPS(0) { IDS(); p0_prologue(P, lds, wave, lane, G); __syncthreads(); } SEAM_FILL(0);
    if (IN(1)) REPS(1) {
        PolP1 S; S.A = (const char*)(ws + WS_RA); S.B = (const char*)(ws + WS_WIN); S.bias = P.b_in; S.rope = (const f32x2*)(ws + WS_ROPE); S.Q = (bf16*)(ws + WS_Q); S.K = (bf16*)(ws + WS_K); S.V = (bf16*)(ws + WS_V);
        S.U = (bf16*)(ws + WS_U); S.G = (bf16*)(ws + WS_G); S.G_ = G; S.c = blockIdx.x;
        pg8::gemm_stream(lds, S);
    } SEAM_FILL(1);
    if (IN(2)) REPS(2) {
        IDS();
        for (int rr_ = 0; rr_ < 1 + ((REP_MASK >> 17) & 1); ++rr_) attn_phase(P, lds, tid, wave, lane, G);
        for (int rr_ = 0; rr_ < 1 + ((REP_MASK >> 18) & 1); ++rr_) pool_phase(P, lds, tid, wave, lane, G);
    } SEAM_FILL(2);
    if (IN(3)) REPS(3) {
        PolP3 S; S.A0 = (const char*)(ws + WS_RA); S.B0 = (const char*)(ws + WS_WO); S.A1 = (const char*)(ws + WS_MIXED); S.B1 = (const char*)(ws + WS_WUP); S.bo = P.b_o;
        S.G = (const bf16*)(ws + WS_G); S.O = ws + WS_MERGED; S.G_ = G; S.c = blockIdx.x;
        pg8::gemm_stream(lds, S);
    } SEAM_FILL(3);
    if (IN(4)) REPS(4) {
        PolP4 S; S.A = (const char*)(ws + WS_MERGED); S.B = (const char*)(ws + WS_WOUT); S.x = P.x; S.out = (bf16*)(ws + WS_X1B); S.ssp = (float*)(ws + WS_SSP); S.G_ = G; S.c = blockIdx.x;
        pg8::gemm_stream(lds, S);
    } SEAM_FILL(4);
    if (IN(5)) { IDS(); p5_rows(P, lds, tid, wave, lane, G, true); conv_run(P, lds, wave, lane, G, []() { return false; }); __syncthreads(); } SEAM(5);
    if (IN(6)) REPS(6) {
        { IDS(); build_tables(P, lds, tid, 0); }
        PolP7 S; S.H2 = (const char*)(ws + WS_H28); S.W = (const char*)(ws + WS_WGU8); S.ltok = (const int*)(ws + WS_LTOK); S.bg = P.b_gate; S.bu = P.b_up;
        S.a = ws + WS_A8; S.tab = tab; S.rbmap = rbmap; S.G_ = G; S.c = blockIdx.x;
        pg8::gemm_stream(lds, S);
    } SEAM(6);
    if (IN(7)) REPS(7) {
        { IDS(); if (!IN(6)) build_tables(P, lds, tid, 0); }
        PolP8 S; S.Aa = (const char*)(ws + WS_A8); S.W = (const char*)(ws + WS_WD8); S.ltok = (const int*)(ws + WS_LTOK); S.bd = P.b_down; S.Y = ws + WS_Y; S.tab = tab; S.rbmap = rbmap; S.G_ = G; S.c = blockIdx.x;
        pg8::gemm_stream(lds, S);
    } SEAM(7);
    if (IN(8)) { IDS(); p9_rows(P, wave, lane, G); }
#undef IN
#undef SEAM
#undef IDS
}

extern "C" void kernel_launch(void* const* d_in, const int* in_sizes, int n_in, void* d_out, int out_size, void* d_ws, size_t ws_size, hipStream_t stream) {
    static int grid = 0;
    if (grid == 0) {
        if (n_in != 22 || out_size != NTOK * D || ws_size < WS_END) { fprintf(stderr, "kernel_launch: unexpected shapes (n_in %d out %d ws %zu)\n", n_in, out_size, ws_size); grid = -1; return; }
        int dev = 0, cus = 0;
        if (hipGetDevice(&dev) != hipSuccess || hipDeviceGetAttribute(&cus, hipDeviceAttributeMultiprocessorCount, dev) != hipSuccess) { grid = -1; return; }
        if (hipFuncSetAttribute((const void*)mk_fwd, hipFuncAttributeMaxDynamicSharedMemorySize, LDS_BYTES) != hipSuccess) { grid = -1; return; }
        int per_cu = 0;
        if (hipOccupancyMaxActiveBlocksPerMultiprocessor(&per_cu, (const void*)mk_fwd, NWAVES * 64, LDS_BYTES) != hipSuccess || per_cu < 1) fprintf(stderr, "kernel_launch: occupancy query says %d\n", per_cu);
        (void)hipGetLastError();
        grid = cus > 0 ? cus : 256;
        if ((size_t)(CW_CONV + 16 * grid) * 4 > CTL_ZERO_BYTES) grid = (int)((CTL_ZERO_BYTES / 4 - CW_CONV) / 16);
    }
    if (grid < 0) return;
    (void)hipMemsetAsync((char*)d_ws + WS_CTL, 0, CTL_ZERO_BYTES, stream);
    Args a{};
    const float** pf = (const float**)&a.p;
    a.p.x = (const float*)d_in[0]; a.p.positions = (const int*)d_in[1]; a.p.norm_mix_g = (const float*)d_in[2]; a.p.w_in = (const float*)d_in[3]; a.p.b_in = (const float*)d_in[4];
    a.p.sinks = (const float*)d_in[5]; a.p.w_o = (const float*)d_in[6]; a.p.b_o = (const float*)d_in[7]; a.p.w_pool_mix = (const float*)d_in[8]; a.p.pool_scale = (const float*)d_in[9];
    a.p.w_pool_up = (const float*)d_in[10]; a.p.w_out = (const float*)d_in[11]; a.p.norm_ffn_g = (const float*)d_in[12]; a.p.w_router = (const float*)d_in[13]; a.p.b_router = (const float*)d_in[14];
    a.p.w_gate = (const float*)d_in[15]; a.p.b_gate = (const float*)d_in[16]; a.p.w_up = (const float*)d_in[17]; a.p.b_up = (const float*)d_in[18]; a.p.w_down = (const float*)d_in[19];
    a.p.b_down = (const float*)d_in[20]; a.p.norm_final_g = (const float*)d_in[21]; a.p.out = (float*)d_out; a.p.ws = (unsigned char*)d_ws;
    (void)pf;
    if (N_LAUNCHES == 1) { a.ph_lo = 0; a.ph_hi = NPHASE; hipLaunchKernelGGL(mk_fwd, dim3(grid), dim3(NWAVES * 64), LDS_BYTES, stream, a); }
    else { for (int ph = 0; ph < NPHASE; ++ph) { a.ph_lo = ph; a.ph_hi = ph + 1; hipLaunchKernelGGL(mk_fwd, dim3(grid), dim3(NWAVES * 64), LDS_BYTES, stream, a); } }
}
```
